# Optimizing an MI355X kernel written in HIP

```python
import math
import jax, jax.numpy as jnp
from jax import lax
import numpy as np

D_MODEL = 1024
BATCH = 4
SEQ = 8192
DEPTH = 1

MEM_LEN = 256
EPS = 1e-6
S5_WIDTH = 512
S5_GROUP = 16
S5_GROUPS = S5_WIDTH // S5_GROUP
S5_STATE = 64
SGU_WIDTH = 1024
SGU_HEADS = 8
SGU_HEAD_DIM = SGU_WIDTH // SGU_HEADS
CHUNK = 128
XATTN_HEADS = 4
XATTN_HEAD_DIM = D_MODEL // XATTN_HEADS
D_FF = ((8 * D_MODEL // 3 + 255) // 256) * 256
OFF_U = S5_WIDTH
OFF_V = OFF_U + SGU_WIDTH
OFF_GA = OFF_V + SGU_WIDTH
OFF_GB = OFF_GA + D_MODEL
IN_COLS = OFF_GB + D_MODEL

kernel_name = "hybrid_s5_gmlp_gated_encoder"


def rms_norm(x, g):
    xf = x.astype(jnp.float32)
    y = xf * lax.rsqrt(jnp.mean(xf * xf, axis=-1, keepdims=True) + EPS)
    return (y * g.astype(jnp.float32)).astype(x.dtype)


def layer_norm(x, g, b):
    xf = x.astype(jnp.float32)
    mu = jnp.mean(xf, axis=-1, keepdims=True)
    xc = xf - mu
    y = xc * lax.rsqrt(jnp.mean(xc * xc, axis=-1, keepdims=True) + EPS)
    return (y * g.astype(jnp.float32) + b.astype(jnp.float32)).astype(x.dtype)


def _linear_recurrence(e1, e2):
    a1, b1 = e1
    a2, b2 = e2
    return a1 * a2, a2 * b1 + b2


def s5_scan(u, lam_re, lam_im, log_step, b_re, b_im, c_re, c_im, reverse):
    f32 = jnp.float32
    seq = u.shape[0]
    lam = lax.complex(lam_re.astype(f32), lam_im.astype(f32))
    step = jnp.exp(log_step.astype(f32))[:, None]
    lam_bar = jnp.exp(lam * step)
    b = lax.complex(b_re.astype(f32), b_im.astype(f32))
    b_bar = ((lam_bar - 1.0) / lam)[..., None] * b
    bu = jnp.einsum('gpc,lbgc->lbgp', b_bar, u.astype(jnp.complex64))
    a = jnp.broadcast_to(lam_bar[None, None], (seq, 1) + lam_bar.shape)
    _, states = lax.associative_scan(_linear_recurrence, (a, bu), axis=0, reverse=reverse)
    c = lax.complex(c_re.astype(f32), c_im.astype(f32))
    return jnp.einsum('gcp,lbgp->lbgc', c, states).real


def s5_branch(xa, lam_re, lam_im, log_step, b_re, b_im, c_re, c_im, d, w_glu):
    f32 = jnp.float32
    bsz, seq, _ = xa.shape
    u = xa.astype(f32).reshape(bsz, seq, S5_GROUPS, S5_GROUP).transpose(1, 0, 2, 3)
    y = d.astype(f32).reshape(S5_GROUPS, S5_GROUP) * u
    for direction, reverse in ((0, False), (1, True)):
        y = y + s5_scan(u, lam_re[direction], lam_im[direction], log_step[direction],
                        b_re[direction], b_im[direction], c_re[direction], c_im[direction],
                        reverse)
    y = jax.nn.gelu(y.transpose(1, 0, 2, 3).reshape(bsz, seq, S5_WIDTH))
    y = y * jax.nn.sigmoid(y @ w_glu.astype(f32))
    return y.astype(xa.dtype)


def sgu_branch(zu, zv, ln_g, ln_b, w_s, bias):
    bsz, seq, _ = zu.shape
    zu = jax.nn.gelu(zu)
    zv = layer_norm(jax.nn.gelu(zv), ln_g, ln_b)
    zv = zv.reshape(bsz, seq // CHUNK, CHUNK, SGU_HEADS, SGU_HEAD_DIM)
    sv = jnp.einsum('hts,bnshd->bnthd', w_s, zv) + bias.T[None, None, :, :, None]
    return zu * sv.reshape(bsz, seq, SGU_WIDTH)


def memory_cross_attention(hn, memn, w_q, w_k, w_v, w_o):
    bsz, seq, _ = hn.shape
    q = (hn @ w_q).reshape(bsz, seq, XATTN_HEADS, XATTN_HEAD_DIM)
    k = (memn @ w_k).reshape(bsz, MEM_LEN, XATTN_HEADS, XATTN_HEAD_DIM)
    v = (memn @ w_v).reshape(bsz, MEM_LEN, XATTN_HEADS, XATTN_HEAD_DIM)
    s = jnp.einsum('blhd,bmhd->bhlm', q, k).astype(jnp.float32) * (XATTN_HEAD_DIM ** -0.5)
    p = jax.nn.softmax(s, axis=-1).astype(v.dtype)
    o = jnp.einsum('bhlm,bmhd->blhd', p, v).reshape(bsz, seq, D_MODEL)
    return o @ w_o


def swiglu(hn, w_gate, w_up, w_down):
    return (jax.nn.silu(hn @ w_gate) * (hn @ w_up)) @ w_down


def setup_inputs(seed: int = 0) -> dict:
    key = jax.random.key(seed)
    ks = iter(jax.random.split(key, 40))
    f32 = jnp.float32

    def nrm(shape, scale):
        return jax.random.normal(next(ks), shape, f32) * scale

    def gain(shape):
        return 1.0 + nrm(shape, 0.02)

    L, G, P, C, H = DEPTH, S5_GROUPS, S5_STATE, S5_GROUP, SGU_HEADS
    n_idx = jnp.arange(P, dtype=f32)
    lam_re = -0.5 + nrm((L, 2, G, P), 0.01)
    lam_im = math.pi * n_idx + nrm((L, 2, G, P), 0.01)
    log_step = jax.random.uniform(next(ks), (L, 2, G), f32, math.log(1e-3), math.log(1e-1))
    return {
        "x": nrm((BATCH, SEQ, D_MODEL), 1.0),
        "mem": nrm((BATCH, MEM_LEN, D_MODEL), 1.0),
        "mix_norm_g": gain((L, D_MODEL)),
        "w_in": nrm((L, D_MODEL, IN_COLS), D_MODEL ** -0.5),
        "s5_lam_re": lam_re,
        "s5_lam_im": lam_im,
        "s5_log_step": log_step,
        "s5_b_re": nrm((L, 2, G, P, C), (2 * C) ** -0.5),
        "s5_b_im": nrm((L, 2, G, P, C), (2 * C) ** -0.5),
        "s5_c_re": nrm((L, 2, G, C, P), (2 * P) ** -0.5),
        "s5_c_im": nrm((L, 2, G, C, P), (2 * P) ** -0.5),
        "s5_d": nrm((L, S5_WIDTH), 1.0),
        "s5_w_glu": nrm((L, S5_WIDTH, S5_WIDTH), S5_WIDTH ** -0.5),
        "sgu_ln_g": gain((L, SGU_WIDTH)),
        "sgu_ln_b": nrm((L, SGU_WIDTH), 0.02),
        "sgu_w": nrm((L, H, CHUNK, CHUNK), 0.5 * CHUNK ** -0.5),
        "sgu_bias": 1.0 + nrm((L, H, CHUNK), 0.02),
        "w_proj_a": nrm((L, S5_WIDTH, D_MODEL), S5_WIDTH ** -0.5),
        "w_proj_b": nrm((L, SGU_WIDTH, D_MODEL), SGU_WIDTH ** -0.5),
        "w_out": nrm((L, D_MODEL, D_MODEL), D_MODEL ** -0.5),
        "xattn_norm_g": gain((L, D_MODEL)),
        "mem_norm_g": gain((D_MODEL,)),
        "w_q": nrm((L, D_MODEL, D_MODEL), D_MODEL ** -0.5),
        "w_k": nrm((L, D_MODEL, D_MODEL), D_MODEL ** -0.5),
        "w_v": nrm((L, D_MODEL, D_MODEL), D_MODEL ** -0.5),
        "w_xo": nrm((L, D_MODEL, D_MODEL), D_MODEL ** -0.5),
        "ffn_norm_g": gain((L, D_MODEL)),
        "w_gate": nrm((L, D_MODEL, D_FF), D_MODEL ** -0.5),
        "w_up": nrm((L, D_MODEL, D_FF), D_MODEL ** -0.5),
        "w_down": nrm((L, D_FF, D_MODEL), D_FF ** -0.5),
        "final_norm_g": gain((D_MODEL,)),
    }


def reference(x, mem, mix_norm_g, w_in, s5_lam_re, s5_lam_im, s5_log_step, s5_b_re, s5_b_im,
              s5_c_re, s5_c_im, s5_d, s5_w_glu, sgu_ln_g, sgu_ln_b, sgu_w, sgu_bias,
              w_proj_a, w_proj_b, w_out, xattn_norm_g, mem_norm_g, w_q, w_k, w_v, w_xo,
              ffn_norm_g, w_gate, w_up, w_down, final_norm_g):
    memn = rms_norm(mem, mem_norm_g)
    h = x
    for i in range(DEPTH):
        n = rms_norm(h, mix_norm_g[i])
        proj = n @ w_in[i]
        xa = proj[..., :OFF_U]
        zu = proj[..., OFF_U:OFF_V]
        zv = proj[..., OFF_V:OFF_GA]
        gate_a = jax.nn.sigmoid(proj[..., OFF_GA:OFF_GB])
        gate_b = jax.nn.sigmoid(proj[..., OFF_GB:])
        ya = s5_branch(xa, s5_lam_re[i], s5_lam_im[i], s5_log_step[i], s5_b_re[i], s5_b_im[i],
                       s5_c_re[i], s5_c_im[i], s5_d[i], s5_w_glu[i])
        yb = sgu_branch(zu, zv, sgu_ln_g[i], sgu_ln_b[i], sgu_w[i], sgu_bias[i])
        merged = gate_a * (ya @ w_proj_a[i]) + gate_b * (yb @ w_proj_b[i])
        h = h + merged @ w_out[i]
        h = h + memory_cross_attention(rms_norm(h, xattn_norm_g[i]), memn,
                                       w_q[i], w_k[i], w_v[i], w_xo[i])
        h = h + swiglu(rms_norm(h, ffn_norm_g[i]), w_gate[i], w_up[i], w_down[i])
    return rms_norm(h, final_norm_g)
```

```cpp
#include <hip/hip_runtime.h>
#include <hip/hip_cooperative_groups.h>
#include <cstdio>
namespace cg = cooperative_groups;

#define LAS __attribute__((address_space(3)))
typedef unsigned short bf16_t;
typedef short bf16x8 __attribute__((ext_vector_type(8)));
typedef float f32x4 __attribute__((ext_vector_type(4)));
typedef unsigned u32x4 __attribute__((ext_vector_type(4)));
typedef unsigned u32x2 __attribute__((ext_vector_type(2)));

constexpr int T_TOK = 32768, DM = 1024, DFF = 2816;
constexpr float EPSV = 1e-6f;
constexpr size_t MiB = 1048576;
constexpr size_t WS_WIN = 0, WS_WGLU = 9 * MiB, WS_WPA = WS_WGLU + MiB / 2, WS_WPB = WS_WPA + MiB, WS_WOUT = WS_WPB + 2 * MiB,
                 WS_WQ = WS_WOUT + 2 * MiB, WS_WK = WS_WQ + 2 * MiB, WS_WV = WS_WK + 2 * MiB, WS_WXO = WS_WV + 2 * MiB,
                 WS_WGU = WS_WXO + 2 * MiB, WS_WD = WS_WGU + 11 * MiB, WS_SW = WS_WD + 6 * MiB, WS_MEMN = WS_SW + MiB,
                 WS_KB = WS_MEMN + 2 * MiB, WS_VT = WS_KB + 2 * MiB, WS_B5 = WS_VT + 2 * MiB, WS_SEND = WS_B5 + 36 * MiB,
                 WS_STAT = WS_SEND + 32 * MiB, WS_A5 = WS_STAT + MiB, WS_R0 = WS_A5 + 48 * MiB, WS_R1 = WS_R0 + 64 * MiB,
                 WS_R2 = WS_R1 + 64 * MiB, WS_R3 = WS_R2 + 64 * MiB, WS_R4 = WS_R3 + 64 * MiB, WS_END = WS_R4 + 64 * MiB;
constexpr size_t WS_BAR = WS_STAT + 768 * 1024;
static_assert(WS_END <= 512 * MiB, "workspace");

struct Params { const float* in[31]; float* out; unsigned char* ws; };

__device__ __forceinline__ unsigned cvt_pk_bf16(float lo, float hi) { unsigned r; asm volatile("v_cvt_pk_bf16_f32 %0, %1, %2" : "=v"(r) : "v"(lo), "v"(hi)); return r; }
__device__ __forceinline__ float bflo(unsigned w) { return __uint_as_float(w << 16); }
__device__ __forceinline__ float bfhi(unsigned w) { return __uint_as_float(w & 0xffff0000u); }
__device__ __forceinline__ float fsigmoid(float x) { return __builtin_amdgcn_rcpf(1.0f + __expf(-x)); }
__device__ __forceinline__ float fgelu(float x) { const float u = 1.5957691216f * (x + 0.044715f * x * x * x); return x * fsigmoid(u); }
__device__ __forceinline__ f32x4 vsigmoid4(const f32x4 x) { const f32x4 t = x * (-1.4426950409f); f32x4 e; e[0] = __builtin_amdgcn_exp2f(t[0]); e[1] = __builtin_amdgcn_exp2f(t[1]); e[2] = __builtin_amdgcn_exp2f(t[2]); e[3] = __builtin_amdgcn_exp2f(t[3]);
    const f32x4 d = e + 1.0f; f32x4 r; r[0] = __builtin_amdgcn_rcpf(d[0]); r[1] = __builtin_amdgcn_rcpf(d[1]); r[2] = __builtin_amdgcn_rcpf(d[2]); r[3] = __builtin_amdgcn_rcpf(d[3]); return r; }
__device__ __forceinline__ f32x4 vgelu4(const f32x4 x) { const f32x4 x2 = x * x; const f32x4 t = x * (x2 * (-1.5957691216f * 0.044715f * 1.4426950409f) + (-1.5957691216f * 1.4426950409f));
    f32x4 e; e[0] = __builtin_amdgcn_exp2f(t[0]); e[1] = __builtin_amdgcn_exp2f(t[1]); e[2] = __builtin_amdgcn_exp2f(t[2]); e[3] = __builtin_amdgcn_exp2f(t[3]);
    const f32x4 d = e + 1.0f; f32x4 r; r[0] = __builtin_amdgcn_rcpf(d[0]); r[1] = __builtin_amdgcn_rcpf(d[1]); r[2] = __builtin_amdgcn_rcpf(d[2]); r[3] = __builtin_amdgcn_rcpf(d[3]); return x * r; }
__device__ __forceinline__ float wave_sum(float v) { v += __shfl_xor(v, 32); v += __shfl_xor(v, 16); v += __shfl_xor(v, 8); v += __shfl_xor(v, 4); v += __shfl_xor(v, 2); v += __shfl_xor(v, 1); return v; }
__device__ __forceinline__ float wave_max(float v) { v = fmaxf(v, __shfl_xor(v, 32)); v = fmaxf(v, __shfl_xor(v, 16)); v = fmaxf(v, __shfl_xor(v, 8)); v = fmaxf(v, __shfl_xor(v, 4)); v = fmaxf(v, __shfl_xor(v, 2)); v = fmaxf(v, __shfl_xor(v, 1)); return v; }
__device__ __forceinline__ u32x4 pack8(const f32x4 a, const f32x4 b) { u32x4 w; w.x = cvt_pk_bf16(a[0], a[1]); w.y = cvt_pk_bf16(a[2], a[3]); w.z = cvt_pk_bf16(b[0], b[1]); w.w = cvt_pk_bf16(b[2], b[3]); return w; }
__device__ __forceinline__ void unpack8(const u32x4 w, f32x4& a, f32x4& b) { a = (f32x4){bflo(w.x), bfhi(w.x), bflo(w.y), bfhi(w.y)}; b = (f32x4){bflo(w.z), bfhi(w.z), bflo(w.w), bfhi(w.w)}; }
__device__ __forceinline__ void cis_rev(double rev, float& c, float& s) { rev -= rint(rev); const float f = (float)rev; c = __builtin_amdgcn_cosf(f); s = __builtin_amdgcn_sinf(f); }

constexpr int BM = 256, BK = 64, HALF = 128, HTB = HALF * BK * 2, NXCD = 8, WGM = 8;
__device__ __forceinline__ int lds_byte(int r, int c) { const int st = (r >> 4) * 2 + (c >> 5), rr = r & 15, cc = c & 31, ob = rr * 64 + cc * 2; return st * 1024 + (ob ^ (((ob >> 9) & 1) << 5)); }
__device__ __forceinline__ void stage_rc(int b, int& R, int& C) { const int st = b / 1024, sb = b % 1024, swz = sb ^ (((sb >> 9) & 1) << 5); R = (st >> 1) * 16 + swz / 64; C = (st & 1) * 32 + (swz % 64) / 2; }
__device__ __forceinline__ int perm32(int rho) { const int n = rho >> 4, i = rho & 15; return 8 * (i >> 2) + 4 * n + (i & 3); }

enum { SCH_STD = 0, SCH_S5Y, SCH_S5E, SCH_ATT_S, SCH_ATT_PV, SCH_QATT };
enum { M_P1 = 0, M_F32, M_BF16, M_MULADD, M_S5Y, M_GLU, M_RES, M_ROWSCALE, M_GU, M_SM, M_MUL, M_RESX };
enum { G_P1 = 0, G_S5E, G_K, G_VT, G_PB, G_S5Y, G_GLU, G_PA, G_OUT, G_Q, G_SC, G_PV, G_XO, G_GU, G_DN };

struct Unit { int pm, pn; size_t ao, bo; };
struct GemmArgs {
    const bf16_t* A; const bf16_t* Bt; int lda, ldb, K, perm, mode, sched, nM, nN, nunits, shift, ldc, i0, i1, rev, cv, wgm;
    void* C; const void* X1; const void* X2; float* F1; bf16_t* H;
};

__device__ __forceinline__ bool sched_next(const GemmArgs& g, int G, int c, int i, Unit& u) {
    if (i >= g.i1) return false;
    const int nr = g.nunits / G; const int ii = (g.rev && nr * G == g.nunits) ? (i < nr ? nr - 1 - i : i) : i;
    const long L = (long)ii * G + c; if (L >= g.nunits) return false;
    int w = (int)L;
    if (g.sched == SCH_QATT || g.sched == SCH_ATT_S || g.sched == SCH_ATT_PV) {
        const int nwg = 512; { const int q = nwg / NXCD, xcd = w % NXCD, off = w / NXCD; w = xcd * q + off; }
        const int pmx = (w >> 5) * 8 + (w & 7), hx = (w & 31) >> 3; w = pmx * 4 + hx;
    }
    if (g.sched == SCH_STD) {
        const int nwg = g.nunits, nN = g.nN, nM = g.nM;
        { const int q = nwg / NXCD, r = nwg % NXCD, xcd = w % NXCD, off = w / NXCD; w = (xcd < r ? xcd * (q + 1) : r * (q + 1) + (xcd - r) * q) + off; }
        const int wgm = g.wgm; const int nig = wgm * nN, gid = w / nig, fm = gid * wgm, gsz = (nM - fm) < wgm ? (nM - fm) : wgm;
        u.pm = fm + ((w % nig) % gsz); u.pn = (w % nig) / gsz;
        u.ao = (size_t)u.pm * 256 * g.lda * 2; u.bo = (size_t)u.pn * 256 * g.ldb * 2;
    } else if (g.sched == SCH_S5Y) {
        const int gg = w >> 3, pml = w & 3, pnl = (w >> 2) & 1;
        u.pm = gg * 4 + pml; u.pn = pnl; u.ao = (size_t)u.pm * 256 * 768 * 2; u.bo = (size_t)(gg * 768 + pnl * 256) * 768 * 2;
    } else if (g.sched == SCH_S5E) {
        const int gg = w >> 2, pml = w & 3;
        u.pm = gg * 4 + pml; u.pn = 0; u.ao = (size_t)u.pm * 256 * 768 * 2; u.bo = (size_t)(gg * 768 + 512) * 768 * 2;
    } else if (g.sched == SCH_QATT) {
        const int pm = w >> 2, h = w & 3;
        u.pm = pm; u.pn = h; u.ao = (size_t)pm * 256 * 1024 * 2; u.bo = (size_t)h * 256 * 1024 * 2;
    } else if (g.sched == SCH_ATT_S) {
        const int pm = w >> 2, h = w & 3;
        u.pm = pm; u.pn = h; u.ao = ((size_t)pm * 256 * 1024 + h * 256) * 2; u.bo = ((size_t)(pm >> 5) * 256 * 1024 + h * 256) * 2;
    } else {
        const int pm = w >> 2, h = w & 3;
        u.pm = pm; u.pn = h; u.ao = ((size_t)pm * 256 * 1024 + h * 256) * 2; u.bo = ((size_t)h * 256 * 1024 + (pm >> 5) * 256) * 2;
    }
    return true;
}

template <int ACT> __device__ __forceinline__ void p1_epi(const f32x4 (&acc)[2][2][4][2], bf16_t* base, int coff, float* zst, int pn, int rbase, int wc, int fq) {
#pragma unroll
    for (int ai = 0; ai < 2; ++ai)
#pragma unroll
        for (int m = 0; m < 4; ++m) {
            const int r = rbase + ai * 128 + m * 16; float s1 = 0.f, s2 = 0.f;
#pragma unroll
            for (int bj = 0; bj < 2; ++bj) {
                const int c = pn * 256 + wc * 64 + bj * 32 + 8 * fq;
                f32x4 v0 = acc[ai][bj][m][0], v1 = acc[ai][bj][m][1];
                bf16_t* dst;
                if (ACT == 0) dst = base + ((size_t)((c >> 4) * 1024 + (r >> 5)) * 768 + (r & 31) * 16 + (c & 15));
                else dst = base + (size_t)r * 1024 + (c - coff);
                if (ACT == 1 || ACT == 2) { v0 = vgelu4(v0); v1 = vgelu4(v1);
                    if (ACT == 2) { const f32x4 sa = v0 + v1, sb = v0 * v0 + v1 * v1; s1 += (sa[0] + sa[1]) + (sa[2] + sa[3]); s2 += (sb[0] + sb[1]) + (sb[2] + sb[3]); } }
                else if (ACT == 3) { v0 = vsigmoid4(v0); v1 = vsigmoid4(v1); }
                __builtin_nontemporal_store(pack8(v0, v1), (u32x4*)dst);
            }
            if (ACT == 2) {
                s1 += __shfl_xor(s1, 16); s1 += __shfl_xor(s1, 32); s2 += __shfl_xor(s2, 16); s2 += __shfl_xor(s2, 32);
                if (fq == 0) { atomicAdd(zst + 2 * r, s1); atomicAdd(zst + 2 * r + 1, s2); }
            }
        }
}

template <int MODE> __device__ __forceinline__ void epilogue(const Params& P, const GemmArgs& g, f32x4 (&acc)[2][2][4][2], const Unit& u, int wr, int wc, int fr, int fq, LAS unsigned char* lds, const float (&ssp)[2][4]) {
    const int rbase = u.pm * 256 + wr * 64 + fr;
    unsigned char* ws = P.ws;
    switch (MODE) {
    case M_P1: {
        const int reg = u.pn;
        if (reg < 2) p1_epi<0>(acc, (bf16_t*)(ws + WS_A5), 0, nullptr, u.pn, rbase, wc, fq);
        else if (reg < 6) p1_epi<1>(acc, (bf16_t*)(ws + WS_R1), 512, nullptr, u.pn, rbase, wc, fq);
        else if (reg < 10) p1_epi<2>(acc, (bf16_t*)(ws + WS_R2), 1536, (float*)(ws + WS_STAT), u.pn, rbase, wc, fq);
        else if (reg < 14) p1_epi<3>(acc, (bf16_t*)(ws + WS_R3), 2560, nullptr, u.pn, rbase, wc, fq);
        else p1_epi<3>(acc, (bf16_t*)(ws + WS_R4), 3584, nullptr, u.pn, rbase, wc, fq);
    } break;
    case M_F32: {
        float* C = (float*)g.C;
#pragma unroll
        for (int ai = 0; ai < 2; ++ai)
#pragma unroll
            for (int m = 0; m < 4; ++m) {
                float* rowp = C + (size_t)(rbase + ai * 128 + m * 16) * g.ldc + u.pn * 256 + wc * 64 + 8 * fq;
#pragma unroll
                for (int bj = 0; bj < 2; ++bj)
#pragma unroll
                    for (int n = 0; n < 2; ++n) *(f32x4*)(rowp + bj * 32 + n * 4) = acc[ai][bj][m][n];
            }
    } break;
    case M_BF16: {
        bf16_t* C = (bf16_t*)g.C;
#pragma unroll
        for (int ai = 0; ai < 2; ++ai)
#pragma unroll
            for (int m = 0; m < 4; ++m) {
                bf16_t* rowp = C + (size_t)(rbase + ai * 128 + m * 16) * g.ldc + u.pn * 256 + wc * 64 + 8 * fq;
#pragma unroll
                for (int bj = 0; bj < 2; ++bj) *(u32x4*)(rowp + bj * 32) = pack8(acc[ai][bj][m][0], acc[ai][bj][m][1]);
            }
    } break;
    case M_MUL:
    case M_MULADD: {
        bf16_t* C = (bf16_t*)g.C; const bf16_t* X1 = (const bf16_t*)g.X1; const bf16_t* X2 = (const bf16_t*)g.X2;
#pragma unroll
        for (int ai = 0; ai < 2; ++ai) {
            u32x4 x1[4][2], x2[4][2];
#pragma unroll
            for (int m = 0; m < 4; ++m)
#pragma unroll
                for (int bj = 0; bj < 2; ++bj) { const size_t off = (size_t)(rbase + ai * 128 + m * 16) * 1024 + u.pn * 256 + wc * 64 + 8 * fq + bj * 32;
                    x1[m][bj] = *(const u32x4*)(X1 + off); if (MODE == M_MULADD) x2[m][bj] = *(const u32x4*)(X2 + off); }
#pragma unroll
            for (int m = 0; m < 4; ++m)
#pragma unroll
                for (int bj = 0; bj < 2; ++bj) { const size_t off = (size_t)(rbase + ai * 128 + m * 16) * 1024 + u.pn * 256 + wc * 64 + 8 * fq + bj * 32;
                    f32x4 a, b; unpack8(x1[m][bj], a, b);
                    f32x4 v0 = acc[ai][bj][m][0] * a, v1 = acc[ai][bj][m][1] * b;
                    if (MODE == M_MULADD) { f32x4 c2, d2; unpack8(x2[m][bj], c2, d2); v0 += c2; v1 += d2; }
                    *(u32x4*)(C + off) = pack8(v0, v1); }
        }
    } break;
    case M_S5Y: {
        bf16_t* C = (bf16_t*)g.C;
#pragma unroll
        for (int ai = 0; ai < 2; ++ai)
#pragma unroll
            for (int m = 0; m < 4; ++m) {
                const int r = rbase + ai * 128 + m * 16; const int gg = r >> 10, ml = r & 1023;
#pragma unroll
                for (int bj = 0; bj < 2; ++bj) {
                    const int n = u.pn * 256 + wc * 64 + bj * 32 + 8 * fq; const int t = n >> 4, co = n & 15;
                    f32x4 v0 = acc[ai][bj][m][0], v1 = acc[ai][bj][m][1];
                    v0 = vgelu4(v0); v1 = vgelu4(v1);
                    *(u32x4*)(C + (size_t)(ml * 32 + t) * 512 + gg * 16 + co) = pack8(v0, v1);
                }
            }
    } break;
    case M_GLU: {
        bf16_t* C = (bf16_t*)g.C; const bf16_t* X1 = (const bf16_t*)g.X1;
#pragma unroll
        for (int ai = 0; ai < 2; ++ai) {
            u32x4 x1[4][2];
#pragma unroll
            for (int m = 0; m < 4; ++m)
#pragma unroll
                for (int bj = 0; bj < 2; ++bj) x1[m][bj] = *(const u32x4*)(X1 + (size_t)(rbase + ai * 128 + m * 16) * 512 + u.pn * 256 + wc * 64 + 8 * fq + bj * 32);
#pragma unroll
            for (int m = 0; m < 4; ++m)
#pragma unroll
                for (int bj = 0; bj < 2; ++bj) {
                    f32x4 a, b; unpack8(x1[m][bj], a, b);
                    f32x4 v0 = acc[ai][bj][m][0], v1 = acc[ai][bj][m][1];
                    v0 = a * vsigmoid4(v0); v1 = b * vsigmoid4(v1);
                    *(u32x4*)(C + (size_t)(rbase + ai * 128 + m * 16) * 512 + u.pn * 256 + wc * 64 + 8 * fq + bj * 32) = pack8(v0, v1);
                }
        }
    } break;
    case M_RESX:
    case M_RES: {
        const float* R = (const float*)g.X1; bf16_t* H = g.H; float* ss = g.F1;
#pragma unroll
        for (int ai = 0; ai < 2; ++ai) {
            f32x4 ra[4][2], rb[4][2];
            if (MODE == M_RESX) {
#pragma unroll
                for (int m = 0; m < 4; ++m)
#pragma unroll
                    for (int bj = 0; bj < 2; ++bj) { const float* p = R + (size_t)(rbase + ai * 128 + m * 16) * 1024 + u.pn * 256 + wc * 64 + 8 * fq + bj * 32;
                        ra[m][bj] = __builtin_nontemporal_load((const f32x4*)p); rb[m][bj] = __builtin_nontemporal_load((const f32x4*)(p + 4)); }
            } else {
                u32x4 w[4][2];
#pragma unroll
                for (int m = 0; m < 4; ++m)
#pragma unroll
                    for (int bj = 0; bj < 2; ++bj) w[m][bj] = *(const u32x4*)(H + (size_t)(rbase + ai * 128 + m * 16) * 1024 + u.pn * 256 + wc * 64 + 8 * fq + bj * 32);
#pragma unroll
                for (int m = 0; m < 4; ++m)
#pragma unroll
                    for (int bj = 0; bj < 2; ++bj) unpack8(w[m][bj], ra[m][bj], rb[m][bj]);
            }
#pragma unroll
            for (int m = 0; m < 4; ++m) {
                const int r = rbase + ai * 128 + m * 16; float sq = 0.f;
#pragma unroll
                for (int bj = 0; bj < 2; ++bj) {
                    const f32x4 a = ra[m][bj] + acc[ai][bj][m][0], b = rb[m][bj] + acc[ai][bj][m][1];
                    sq += a[0] * a[0] + a[1] * a[1] + a[2] * a[2] + a[3] * a[3] + b[0] * b[0] + b[1] * b[1] + b[2] * b[2] + b[3] * b[3];
                    *(u32x4*)(H + (size_t)r * 1024 + u.pn * 256 + wc * 64 + 8 * fq + bj * 32) = pack8(a, b);
                }
                sq += __shfl_xor(sq, 16); sq += __shfl_xor(sq, 32);
                if (fq == 0) atomicAdd(ss + r, sq);
            }
        }
    } break;
    case M_ROWSCALE: {
        bf16_t* C = (bf16_t*)g.C; float ssv[2][4];
#pragma unroll
        for (int ai = 0; ai < 2; ++ai)
#pragma unroll
            for (int m = 0; m < 4; ++m) ssv[ai][m] = ssp[ai][m];
#pragma unroll
        for (int ai = 0; ai < 2; ++ai)
#pragma unroll
            for (int m = 0; m < 4; ++m) {
                const int r = rbase + ai * 128 + m * 16; const float rs = rsqrtf(ssv[ai][m] * (1.0f / 1024.0f) + EPSV);
                bf16_t* rowp = C + (size_t)r * 1024 + u.pn * 256 + wc * 64 + 8 * fq;
#pragma unroll
                for (int bj = 0; bj < 2; ++bj) *(u32x4*)(rowp + bj * 32) = pack8(acc[ai][bj][m][0] * rs, acc[ai][bj][m][1] * rs);
            }
    } break;
    case M_GU: {
        bf16_t* C = (bf16_t*)g.C; float ssv[2][4];
#pragma unroll
        for (int ai = 0; ai < 2; ++ai)
#pragma unroll
            for (int m = 0; m < 4; ++m) ssv[ai][m] = ssp[ai][m];
#pragma unroll
        for (int ai = 0; ai < 2; ++ai)
#pragma unroll
            for (int m = 0; m < 4; ++m) {
                const int r = rbase + ai * 128 + m * 16; const float rs = rsqrtf(ssv[ai][m] * (1.0f / 1024.0f) + EPSV);
                const f32x4 g0 = acc[ai][0][m][0] * rs, g1 = acc[ai][0][m][1] * rs;
                const f32x4 v0 = g0 * vsigmoid4(g0) * (acc[ai][1][m][0] * rs), v1 = g1 * vsigmoid4(g1) * (acc[ai][1][m][1] * rs);
                __builtin_nontemporal_store(pack8(v0, v1), (u32x4*)(C + (size_t)r * DFF + u.pn * 128 + wc * 32 + 8 * fq));
            }
    } break;
    case M_SM: {
        bf16_t* C = (bf16_t*)g.C;
        LAS float* redm = (LAS float*)(lds + 131072 + 16); LAS float* reds = redm + 1024;
#pragma unroll
        for (int ai = 0; ai < 2; ++ai)
#pragma unroll
            for (int m = 0; m < 4; ++m) {
                float v = -3.0e38f;
#pragma unroll
                for (int bj = 0; bj < 2; ++bj)
#pragma unroll
                    for (int n = 0; n < 2; ++n) { const f32x4 x = acc[ai][bj][m][n]; v = fmaxf(v, fmaxf(fmaxf(x[0], x[1]), fmaxf(x[2], x[3]))); }
                v = fmaxf(v, __shfl_xor(v, 16)); v = fmaxf(v, __shfl_xor(v, 32));
                if (fq == 0) redm[(ai * 128 + wr * 64 + m * 16 + fr) * 4 + wc] = v;
            }
        asm volatile("s_waitcnt lgkmcnt(0)" ::: "memory"); __builtin_amdgcn_s_barrier(); asm volatile("" ::: "memory");
#pragma unroll
        for (int ai = 0; ai < 2; ++ai)
#pragma unroll
            for (int m = 0; m < 4; ++m) {
                const int row = ai * 128 + wr * 64 + m * 16 + fr; const f32x4 q = *(const LAS f32x4*)(redm + row * 4);
                const float M = fmaxf(fmaxf(q[0], q[1]), fmaxf(q[2], q[3])); float sum = 0.f;
#pragma unroll
                for (int bj = 0; bj < 2; ++bj)
#pragma unroll
                    for (int n = 0; n < 2; ++n) { f32x4 x = acc[ai][bj][m][n];
#pragma unroll
                        for (int j = 0; j < 4; ++j) { x[j] = __expf(x[j] - M); sum += x[j]; }
                        acc[ai][bj][m][n] = x; }
                sum += __shfl_xor(sum, 16); sum += __shfl_xor(sum, 32);
                if (fq == 0) reds[row * 4 + wc] = sum;
            }
        asm volatile("s_waitcnt lgkmcnt(0)" ::: "memory"); __builtin_amdgcn_s_barrier(); asm volatile("" ::: "memory");
#pragma unroll
        for (int ai = 0; ai < 2; ++ai)
#pragma unroll
            for (int m = 0; m < 4; ++m) {
                const int row = ai * 128 + wr * 64 + m * 16 + fr; const f32x4 q = *(const LAS f32x4*)(reds + row * 4);
                const float inv = 1.0f / ((q[0] + q[1]) + (q[2] + q[3]));
                bf16_t* rowp = C + (size_t)(rbase + ai * 128 + m * 16) * 1024 + u.pn * 256 + wc * 64 + 8 * fq;
#pragma unroll
                for (int bj = 0; bj < 2; ++bj) *(u32x4*)(rowp + bj * 32) = pack8(acc[ai][bj][m][0] * inv, acc[ai][bj][m][1] * inv);
            }
    } break;
    }
}

template <int MODE> __device__ __forceinline__ void gemm_phase(const Params& P, LAS unsigned char* lds, const GemmArgs& g) {
    int tid = threadIdx.x; asm volatile("" : "+v"(tid));
    const int wid = __builtin_amdgcn_readfirstlane(tid >> 6), lane = tid & 63, wr = wid >> 2, wc = wid & 3, fr = lane & 15, fq = lane >> 4;
    const int G = (int)gridDim.x, cidx = (int)(((unsigned)(g.cv >= 0 ? g.cv : (int)blockIdx.x) + gridDim.x - (unsigned)g.shift) % gridDim.x);
    const int K = g.K, nt = K / BK;
    unsigned voffA[2], voffB[2];
#pragma unroll
    for (int i = 0; i < 2; ++i) { int R, C; stage_rc(tid * 16 + i * 8192, R, C); const int Rb = g.perm ? ((R >> 5) * 64 + perm32(R & 31)) : R;
        voffA[i] = (unsigned)(R * g.lda + C) * 2u; voffB[i] = (unsigned)(Rb * g.ldb + C) * 2u; }
    const size_t kstep = (size_t)(BK * 2);
    const size_t hstepA = (size_t)HALF * g.lda * 2, hstepB = (size_t)(g.perm ? 32 : HALF) * g.ldb * 2;
    const unsigned ldsw = (unsigned)wid * 1024u;
    const int aoff = lds_byte(wr * 64 + fr, fq * 8), boff = lds_byte(wc * 32 + fr, fq * 8);
#define PG8_SA(b, h) (((b) * 2 + (h)) * HTB)
#define PG8_SB(b, h) ((4 + (b) * 2 + (h)) * HTB)
#define PG8_STAGE(bufoff, gbase, voff) do { _Pragma("unroll") for (int _i = 0; _i < 2; ++_i) \
        __builtin_amdgcn_global_load_lds((const unsigned*)((const char*)(gbase) + (voff)[_i]), (LAS unsigned*)(lds + (bufoff) + ldsw + _i * 8192), 16, 0, 0); } while (0)
#define PG8_LDA(dst, b, h) do { _Pragma("unroll") for (int m = 0; m < 4; ++m) _Pragma("unroll") for (int k = 0; k < 2; ++k) dst[m][k] = *(const LAS bf16x8*)(lds + PG8_SA(b, h) + aoff + m * 2048 + k * 1024); } while (0)
#define PG8_LDB(dst, b, h) do { _Pragma("unroll") for (int n = 0; n < 2; ++n) _Pragma("unroll") for (int k = 0; k < 2; ++k) dst[n][k] = *(const LAS bf16x8*)(lds + PG8_SB(b, h) + boff + n * 2048 + k * 1024); } while (0)
#define PG8_MMA(ai, bj, At, Bt) do { __builtin_amdgcn_s_setprio(1); _Pragma("unroll") for (int m = 0; m < 4; ++m) _Pragma("unroll") for (int n = 0; n < 2; ++n) _Pragma("unroll") for (int k = 0; k < 2; ++k) \
        acc[ai][bj][m][n] = __builtin_amdgcn_mfma_f32_16x16x32_bf16(Bt[n][k], At[m][k], acc[ai][bj][m][n], 0, 0, 0); __builtin_amdgcn_s_setprio(0); } while (0)
#define PG8_WAIT_V(n) asm volatile("s_waitcnt vmcnt(" #n ")" ::: "memory")
#define PG8_WAIT_L(n) asm volatile("s_waitcnt lgkmcnt(" #n ")" ::: "memory")
#define PG8_BAR __builtin_amdgcn_s_barrier()
#define PG8_SCHED __builtin_amdgcn_sched_barrier(0)
    Unit cur, nxt; int ui = g.i0;
    if (!sched_next(g, G, cidx, ui, cur)) return;
    f32x4 acc[2][2][4][2];
#pragma unroll
    for (int a = 0; a < 2; ++a)
#pragma unroll
        for (int b = 0; b < 2; ++b)
#pragma unroll
            for (int m = 0; m < 4; ++m)
#pragma unroll
                for (int n = 0; n < 2; ++n) acc[a][b][m][n] = (f32x4){0.f, 0.f, 0.f, 0.f};
    bf16x8 At[4][2], B0[2][2], B1[2][2];
    const char* cA = (const char*)g.A + cur.ao; const char* cB = (const char*)g.Bt + cur.bo;
    PG8_STAGE(PG8_SB(0, 0), cB, voffB); PG8_STAGE(PG8_SA(0, 0), cA, voffA); PG8_STAGE(PG8_SB(0, 1), cB + hstepB, voffB); PG8_STAGE(PG8_SA(0, 1), cA + hstepA, voffA);
    if (wr == 1) PG8_BAR;
    PG8_WAIT_V(4); PG8_BAR;
    PG8_STAGE(PG8_SB(1, 0), cB + kstep, voffB); PG8_STAGE(PG8_SA(1, 0), cA + kstep, voffA); PG8_STAGE(PG8_SB(1, 1), cB + hstepB + kstep, voffB);
    PG8_WAIT_V(6); PG8_BAR;
    float ssp[2][4];
#pragma unroll
    for (int a = 0; a < 2; ++a)
#pragma unroll
        for (int m = 0; m < 4; ++m) ssp[a][m] = 0.f;
    for (;;) {
        if (MODE == M_GU || MODE == M_ROWSCALE) {
            const float* ssg = g.F1 + cur.pm * 256 + wr * 64 + fr;
#pragma unroll
            for (int a = 0; a < 2; ++a)
#pragma unroll
                for (int m = 0; m < 4; ++m) ssp[a][m] = ssg[a * 128 + m * 16];
        }
        const bool has_next = sched_next(g, G, cidx, ui + 1, nxt);
        const char* nA = has_next ? (const char*)g.A + nxt.ao : cA; const char* nB = has_next ? (const char*)g.Bt + nxt.bo : cB;
        for (int t = 0; t < nt; t += 2) {
            const bool last = (t == nt - 2);
            const char* a1 = cA + (size_t)(t + 1) * kstep;
            const char* a2 = last ? nA : cA + (size_t)(t + 2) * kstep; const char* b2 = last ? nB : cB + (size_t)(t + 2) * kstep;
            const char* a3 = a2 + kstep; const char* b3 = b2 + kstep;
            PG8_LDB(B0, 0, 0); PG8_SCHED; PG8_LDA(At, 0, 0); PG8_STAGE(PG8_SA(1, 1), a1 + hstepA, voffA);
            PG8_WAIT_L(8); PG8_BAR; PG8_WAIT_L(0); PG8_MMA(0, 0, At, B0); PG8_BAR; PG8_SCHED;
            PG8_LDB(B1, 0, 1); PG8_STAGE(PG8_SB(0, 0), b2, voffB);
            PG8_BAR; PG8_WAIT_L(0); PG8_MMA(0, 1, At, B1); PG8_BAR;
            PG8_LDA(At, 0, 1); PG8_STAGE(PG8_SA(0, 0), a2, voffA);
            PG8_BAR; PG8_WAIT_L(0); PG8_MMA(1, 0, At, B0); PG8_BAR; PG8_SCHED;
            PG8_STAGE(PG8_SB(0, 1), b2 + hstepB, voffB);
            PG8_WAIT_V(6); PG8_BAR; PG8_MMA(1, 1, At, B1); PG8_BAR;
            PG8_LDB(B0, 1, 0); PG8_SCHED; PG8_LDA(At, 1, 0); PG8_STAGE(PG8_SA(0, 1), a2 + hstepA, voffA);
            PG8_WAIT_L(8); PG8_BAR; PG8_WAIT_L(0); PG8_MMA(0, 0, At, B0); PG8_BAR; PG8_SCHED;
            PG8_LDB(B1, 1, 1); PG8_STAGE(PG8_SB(1, 0), b3, voffB);
            PG8_BAR; PG8_WAIT_L(0); PG8_MMA(0, 1, At, B1); PG8_BAR;
            PG8_LDA(At, 1, 1); PG8_STAGE(PG8_SA(1, 0), a3, voffA);
            PG8_BAR; PG8_WAIT_L(0); PG8_MMA(1, 0, At, B0); PG8_BAR; PG8_SCHED;
            PG8_STAGE(PG8_SB(1, 1), b3 + hstepB, voffB);
            PG8_WAIT_V(6); PG8_BAR; PG8_MMA(1, 1, At, B1); PG8_BAR;
        }
        epilogue<MODE>(P, g, acc, cur, wr, wc, fr, fq, lds, ssp);
        if (!has_next) break;
#pragma unroll
        for (int a = 0; a < 2; ++a)
#pragma unroll
            for (int b = 0; b < 2; ++b)
#pragma unroll
                for (int m = 0; m < 4; ++m)
#pragma unroll
                    for (int n = 0; n < 2; ++n) acc[a][b][m][n] = (f32x4){0.f, 0.f, 0.f, 0.f};
        cur = nxt; cA = nA; cB = nB; ++ui;
    }
    PG8_WAIT_V(0);
    if (wr == 0) PG8_BAR;
    PG8_BAR;
#undef PG8_SA
#undef PG8_SB
#undef PG8_STAGE
#undef PG8_LDA
#undef PG8_LDB
#undef PG8_MMA
#undef PG8_WAIT_V
#undef PG8_WAIT_L
#undef PG8_BAR
#undef PG8_SCHED
}

__device__ __forceinline__ void make_gemm(const Params& P, int id, GemmArgs& g) {
    unsigned char* ws = P.ws;
    g.shift = 0; g.i0 = 0; g.i1 = 1 << 20; g.rev = 0; g.cv = -1; g.wgm = WGM; g.X1 = nullptr; g.X2 = nullptr; g.F1 = nullptr; g.H = nullptr; g.C = nullptr; g.ldc = 1024; g.nM = 128; g.nN = 4;
    g.lda = 1024; g.ldb = 1024; g.K = 1024; g.perm = 1; g.sched = SCH_STD;
    switch (id) {
    case G_P1: g.A = (const bf16_t*)(ws + WS_R0); g.Bt = (const bf16_t*)(ws + WS_WIN); g.mode = M_P1; g.nN = 18; break;
    case G_S5E: g.A = (const bf16_t*)(ws + WS_A5); g.Bt = (const bf16_t*)(ws + WS_B5); g.lda = 768; g.ldb = 768; g.K = 512; g.mode = M_F32; g.sched = SCH_S5E;
        g.C = ws + WS_SEND; g.ldc = 256; g.nunits = 128; return;
    case G_K: g.A = (const bf16_t*)(ws + WS_MEMN); g.Bt = (const bf16_t*)(ws + WS_WK); g.mode = M_BF16; g.C = ws + WS_KB; g.nM = 4; g.nN = 4; g.shift = 128; break;
    case G_VT: g.A = (const bf16_t*)(ws + WS_WV); g.Bt = (const bf16_t*)(ws + WS_MEMN); g.mode = M_BF16; g.C = ws + WS_VT; g.nM = 4; g.nN = 4; g.shift = 144; break;
    case G_PB: g.rev = 1; g.A = (const bf16_t*)(ws + WS_R0); g.Bt = (const bf16_t*)(ws + WS_WPB); g.mode = M_MUL; g.C = ws + WS_R1; g.X1 = ws + WS_R4; break;
    case G_S5Y: g.A = (const bf16_t*)(ws + WS_A5); g.Bt = (const bf16_t*)(ws + WS_B5); g.lda = 768; g.ldb = 768; g.K = 768; g.mode = M_S5Y; g.sched = SCH_S5Y;
        g.C = ws + WS_R2; g.nunits = 256; return;
    case G_GLU: g.A = (const bf16_t*)(ws + WS_R2); g.Bt = (const bf16_t*)(ws + WS_WGLU); g.lda = 512; g.ldb = 512; g.K = 512; g.mode = M_GLU; g.C = ws + WS_R2 + 32 * MiB; g.X1 = ws + WS_R2; g.nN = 2; break;
    case G_PA: g.A = (const bf16_t*)(ws + WS_R2 + 32 * MiB); g.Bt = (const bf16_t*)(ws + WS_WPA); g.lda = 512; g.ldb = 512; g.K = 512; g.mode = M_MULADD; g.C = ws + WS_R0; g.X1 = ws + WS_R3; g.X2 = ws + WS_R1; break;
    case G_OUT: g.rev = 1; g.A = (const bf16_t*)(ws + WS_R0); g.Bt = (const bf16_t*)(ws + WS_WOUT); g.mode = M_RESX; g.X1 = P.in[0]; g.H = (bf16_t*)(ws + WS_R1); g.F1 = (float*)(ws + WS_STAT) + 2 * T_TOK; break;
    case G_Q: g.A = (const bf16_t*)(ws + WS_R1); g.Bt = (const bf16_t*)(ws + WS_WQ); g.mode = M_ROWSCALE; g.C = ws + WS_R0; g.F1 = (float*)(ws + WS_STAT) + 2 * T_TOK; break;
    case G_SC: g.A = (const bf16_t*)(ws + WS_R0); g.Bt = (const bf16_t*)(ws + WS_KB); g.K = 256; g.mode = M_SM; g.sched = SCH_ATT_S; g.C = ws + WS_R3; g.nunits = 512; return;
    case G_PV: g.A = (const bf16_t*)(ws + WS_R3); g.Bt = (const bf16_t*)(ws + WS_VT); g.K = 256; g.mode = M_BF16; g.sched = SCH_ATT_PV; g.C = ws + WS_R0; g.nunits = 512; return;
    case G_XO: g.rev = 1; g.A = (const bf16_t*)(ws + WS_R0); g.Bt = (const bf16_t*)(ws + WS_WXO); g.mode = M_RES; g.H = (bf16_t*)(ws + WS_R1); g.F1 = (float*)(ws + WS_STAT) + 3 * T_TOK; break;
    case G_GU: g.A = (const bf16_t*)(ws + WS_R1); g.Bt = (const bf16_t*)(ws + WS_WGU); g.mode = M_GU; g.C = ws + WS_R2; g.F1 = (float*)(ws + WS_STAT) + 3 * T_TOK; g.nN = 22; break;
    default:   g.rev = 1; g.wgm = 16; g.A = (const bf16_t*)(ws + WS_R2); g.Bt = (const bf16_t*)(ws + WS_WD); g.lda = DFF; g.ldb = DFF; g.K = DFF; g.mode = M_RES; g.H = (bf16_t*)(ws + WS_R1); g.F1 = (float*)(ws + WS_STAT) + 4 * T_TOK; break;
    }
    g.nunits = g.nM * g.nN;
}

__device__ __forceinline__ void prep_rows(const float* x, const float* gn, bf16_t* out, int nrows) {
    int tidl = threadIdx.x; asm volatile("" : "+v"(tidl)); const int wid = tidl >> 6, lane = tidl & 63;
    f32x4 g4[4];
#pragma unroll
    for (int i = 0; i < 4; ++i) g4[i] = ((const f32x4*)gn)[lane + 64 * i];
    for (int row0 = (blockIdx.x * 8 + wid) * 4; row0 < nrows; row0 += gridDim.x * 32) {
        f32x4 v[4][4];
#pragma unroll
        for (int rr = 0; rr < 4; ++rr) { const f32x4* p = (const f32x4*)(x + (size_t)(row0 + rr) * 1024);
#pragma unroll
            for (int i = 0; i < 4; ++i) v[rr][i] = __builtin_nontemporal_load(p + lane + 64 * i); }
#pragma unroll
        for (int rr = 0; rr < 4; ++rr) {
            float ss = 0.f;
#pragma unroll
            for (int i = 0; i < 4; ++i) ss += v[rr][i][0] * v[rr][i][0] + v[rr][i][1] * v[rr][i][1] + v[rr][i][2] * v[rr][i][2] + v[rr][i][3] * v[rr][i][3];
            ss = wave_sum(ss); const float rs = rsqrtf(ss * (1.0f / 1024.0f) + EPSV);
#pragma unroll
            for (int i = 0; i < 4; ++i) { const f32x4 o = v[rr][i] * rs * g4[i]; u32x2 w; w.x = cvt_pk_bf16(o[0], o[1]); w.y = cvt_pk_bf16(o[2], o[3]);
                *(u32x2*)(out + (size_t)(row0 + rr) * 1024 + (lane + 64 * i) * 4) = w; }
        }
    }
}

__device__ __forceinline__ void transpose_strip(LAS float* tile, const float* src, int N, bf16_t* dst, int ldd, int mapmode, const float* kscale, float cscale, int tk, int tn) {
    int tid = threadIdx.x; asm volatile("" : "+v"(tid)); const int k0 = tk * 64, n0 = tn * 256;
    f32x4 v[8];
#pragma unroll
    for (int rr = 0; rr < 8; ++rr) { const int i = (tid >> 6) + 8 * rr, j = (tid & 63) * 4; v[rr] = __builtin_nontemporal_load((const f32x4*)(src + (size_t)(k0 + i) * N + n0 + j)); }
#pragma unroll
    for (int rr = 0; rr < 8; ++rr) { const int i = (tid >> 6) + 8 * rr, j = (tid & 63) * 4; const float sc = (kscale ? kscale[k0 + i] : 1.0f) * cscale;
        tile[i * 257 + j] = v[rr][0] * sc; tile[i * 257 + j + 1] = v[rr][1] * sc; tile[i * 257 + j + 2] = v[rr][2] * sc; tile[i * 257 + j + 3] = v[rr][3] * sc; }
    __syncthreads();
#pragma unroll
    for (int q = 0; q < 4; ++q) { const int n = (tid >> 3) + 64 * q, kk = (tid & 7) * 8; f32x4 a, b;
#pragma unroll
        for (int j = 0; j < 4; ++j) { a[j] = tile[(kk + j) * 257 + n]; b[j] = tile[(kk + 4 + j) * 257 + n]; }
        int c = n0 + n; if (mapmode) c = (c >> 7) * 256 + ((c & 127) >> 5) * 64 + (mapmode == 2 ? 32 : 0) + (c & 31);
        *(u32x4*)(dst + (size_t)c * ldd + k0 + kk) = pack8(a, b); }
    __syncthreads();
}

__device__ __forceinline__ void s5_prep_item(const Params& P, LAS unsigned char* lds, int item) {
    const int gg = item >> 3, part = item & 7, tid = threadIdx.x;
    LAS float* LPr = (LAS float*)lds; LAS float* LPi = LPr + 4224; LAS float* BBr = LPi + 4224; LAS float* BBi = BBr + 2048;
    LAS float* CCr = BBi + 2048; LAS float* CCi = CCr + 2048; LAS float* KK = CCi + 2048;
    const float* lam_re = P.in[4]; const float* lam_im = P.in[5]; const float* lstep = P.in[6];
    const float* b_re = P.in[7]; const float* b_im = P.in[8]; const float* c_re = P.in[9]; const float* c_im = P.in[10]; const float* dsk = P.in[11];
    const double INV2PI = 0.15915494309189533577;
    for (int idx = tid; idx < 4224; idx += 512) {
        const int dir = idx / 2112, rem = idx % 2112, tau = rem >> 6, p = rem & 63, q = (dir * 32 + gg) * 64 + p;
        const float step = expf(lstep[dir * 32 + gg]); const float zr = lam_re[q] * step; const double zi = (double)lam_im[q] * (double)step;
        const float mag = expf((float)tau * zr); float c, s; cis_rev(zi * (double)tau * INV2PI, c, s);
        LPr[idx] = mag * c; LPi[idx] = mag * s;
    }
    for (int idx = tid; idx < 2048; idx += 512) {
        const int dir = idx >> 10, p = (idx >> 4) & 63, ci = idx & 15, q = (dir * 32 + gg) * 64 + p;
        const float lr = lam_re[q], li = lam_im[q]; const float step = expf(lstep[dir * 32 + gg]); const float zr = lr * step; const double zi = (double)li * (double)step;
        float c, s, ch, sh; cis_rev(zi * INV2PI, c, s); cis_rev(zi * INV2PI * 0.5, ch, sh);
        const float em1 = expm1f(zr); const float nr = em1 * c - 2.0f * sh * sh, ni = (1.0f + em1) * s;
        const float den = 1.0f / (lr * lr + li * li); const float qr = (nr * lr + ni * li) * den, qi = (ni * lr - nr * li) * den;
        const float br = b_re[q * 16 + ci], bi = b_im[q * 16 + ci];
        BBr[idx] = qr * br - qi * bi; BBi[idx] = qr * bi + qi * br;
    }
    for (int idx = tid; idx < 2048; idx += 512) {
        const int dir = idx >> 10, co = (idx >> 6) & 15, p = idx & 63; const int q = ((dir * 32 + gg) * 16 + co) * 64 + p;
        CCr[idx] = c_re[q]; CCi[idx] = c_im[q];
    }
    __syncthreads();
    bf16_t* B5g = (bf16_t*)(P.ws + WS_B5) + (size_t)gg * 768 * 768;
    if (part < 4) {
        for (int idx = tid; idx < 4096; idx += 512) {
            const int dir = idx >> 11, tl = (idx >> 8) & 7, co = (idx >> 4) & 15, ci = idx & 15, tau = part * 8 + tl; float sum = 0.f;
            for (int p = 0; p < 64; ++p) {
                const float cr = CCr[dir * 1024 + co * 64 + p], cim = CCi[dir * 1024 + co * 64 + p], lr = LPr[dir * 2112 + tau * 64 + p], li = LPi[dir * 2112 + tau * 64 + p];
                const float xr = cr * lr - cim * li, xi = cr * li + cim * lr;
                sum += xr * BBr[dir * 1024 + p * 16 + ci] - xi * BBi[dir * 1024 + p * 16 + ci];
            }
            KK[idx] = sum;
        }
        __syncthreads();
        for (int task = tid; task < 8192; task += 512) {
            const int co = task & 15, tt = (task >> 4) & 31, tl = (task >> 9) & 7, dir = task >> 12, tau = part * 8 + tl;
            int s;
            if (dir == 0) { s = tt - tau; if (s < 0) continue; } else { if (tau == 0) continue; s = tt + tau; if (s > 31) continue; }
            const float dval = dsk[gg * 16 + co];
            f32x4 v[4];
#pragma unroll
            for (int ci = 0; ci < 16; ++ci) {
                float x = KK[dir * 2048 + tl * 256 + co * 16 + ci];
                if (tau == 0) { x += KK[2048 + tl * 256 + co * 16 + ci]; if (ci == co) x += dval; }
                v[ci >> 2][ci & 3] = x;
            }
            bf16_t* dst = B5g + (size_t)(tt * 16 + co) * 768 + s * 16;
            *(u32x4*)dst = pack8(v[0], v[1]); *(u32x4*)(dst + 8) = pack8(v[2], v[3]);
        }
    } else if (part < 6) {
        const int dir = part - 4;
        for (int task = tid; task < 4096; task += 512) {
            const int s = task & 31, rr = task >> 5, p = rr & 63, isim = rr >> 6; const int e = dir == 0 ? 31 - s : s;
            const float lr = LPr[dir * 2112 + e * 64 + p], li = LPi[dir * 2112 + e * 64 + p];
            f32x4 v[4];
#pragma unroll
            for (int ci = 0; ci < 16; ++ci) { const float br = BBr[dir * 1024 + p * 16 + ci], bi = BBi[dir * 1024 + p * 16 + ci]; v[ci >> 2][ci & 3] = isim ? (lr * bi + li * br) : (lr * br - li * bi); }
            bf16_t* dst = B5g + (size_t)(512 + dir * 128 + rr) * 768 + s * 16;
            *(u32x4*)dst = pack8(v[0], v[1]); *(u32x4*)(dst + 8) = pack8(v[2], v[3]);
        }
    } else {
        const int dir = part - 6;
        for (int task = tid; task < 4096; task += 512) {
            const int p8 = task & 7, n = task >> 3, t = n >> 4, co = n & 15; const int e = dir == 0 ? t + 1 : 32 - t;
            f32x4 vr[2], vi[2];
#pragma unroll
            for (int j = 0; j < 8; ++j) { const int p = p8 * 8 + j; const float cr = CCr[dir * 1024 + co * 64 + p], cim = CCi[dir * 1024 + co * 64 + p], lr = LPr[dir * 2112 + e * 64 + p], li = LPi[dir * 2112 + e * 64 + p];
                vr[j >> 2][j & 3] = cr * lr - cim * li; vi[j >> 2][j & 3] = -(cr * li + cim * lr); }
            bf16_t* dst = B5g + (size_t)n * 768 + 512 + dir * 128 + p8 * 8;
            *(u32x4*)dst = pack8(vr[0], vr[1]); *(u32x4*)(dst + 64) = pack8(vi[0], vi[1]);
        }
    }
    __syncthreads();
}

__device__ __forceinline__ void phase_prep(const Params& P, LAS unsigned char* lds) {
    unsigned char* ws = P.ws; const int tid = threadIdx.x;
    { float* st = (float*)(ws + WS_STAT); for (int i = blockIdx.x * 512 + tid; i < 5 * T_TOK; i += gridDim.x * 512) st[i] = 0.f; }
#pragma unroll 1
    for (int step = 0; step < 2; ++step) {
    if (((step ^ (int)(blockIdx.x & 1u)) & 1) == 0) {
    for (int item = blockIdx.x; item < 256; item += gridDim.x) s5_prep_item(P, lds, item);
    { const float* sw = P.in[15]; bf16_t* o = (bf16_t*)(ws + WS_SW); for (int i = (blockIdx.x * 512 + tid) * 4; i < 8 * 128 * 128; i += gridDim.x * 512 * 4) { const f32x4 v = *(const f32x4*)(sw + i); u32x2 w; w.x = cvt_pk_bf16(v[0], v[1]); w.y = cvt_pk_bf16(v[2], v[3]); *(u32x2*)(o + i) = w; } }
    LAS float* tile = (LAS float*)lds;
    for (int j = blockIdx.x; j < 1248; j += gridDim.x) {
        int t = j; const float* src; int N, ldd, mapmode = 0; bf16_t* dst; const float* ks = nullptr; float cs = 1.0f; int nTn;
        if (t < 288) { src = P.in[3]; N = 4608; dst = (bf16_t*)(ws + WS_WIN); ldd = 1024; nTn = 18; }
        else if ((t -= 288) < 16) { src = P.in[12]; N = 512; dst = (bf16_t*)(ws + WS_WGLU); ldd = 512; nTn = 2; }
        else if ((t -= 16) < 32) { src = P.in[17]; N = 1024; dst = (bf16_t*)(ws + WS_WPA); ldd = 512; nTn = 4; }
        else if ((t -= 32) < 64) { src = P.in[18]; N = 1024; dst = (bf16_t*)(ws + WS_WPB); ldd = 1024; nTn = 4; }
        else if ((t -= 64) < 64) { src = P.in[19]; N = 1024; dst = (bf16_t*)(ws + WS_WOUT); ldd = 1024; nTn = 4; }
        else if ((t -= 64) < 64) { src = P.in[22]; N = 1024; dst = (bf16_t*)(ws + WS_WQ); ldd = 1024; nTn = 4; ks = P.in[20]; cs = 0.0625f; }
        else if ((t -= 64) < 64) { src = P.in[23]; N = 1024; dst = (bf16_t*)(ws + WS_WK); ldd = 1024; nTn = 4; }
        else if ((t -= 64) < 64) { src = P.in[24]; N = 1024; dst = (bf16_t*)(ws + WS_WV); ldd = 1024; nTn = 4; }
        else if ((t -= 64) < 64) { src = P.in[25]; N = 1024; dst = (bf16_t*)(ws + WS_WXO); ldd = 1024; nTn = 4; }
        else if ((t -= 64) < 176) { src = P.in[27]; N = 2816; dst = (bf16_t*)(ws + WS_WGU); ldd = 1024; nTn = 11; ks = P.in[26]; mapmode = 1; }
        else if ((t -= 176) < 176) { src = P.in[28]; N = 2816; dst = (bf16_t*)(ws + WS_WGU); ldd = 1024; nTn = 11; ks = P.in[26]; mapmode = 2; }
        else { t -= 176; src = P.in[29]; N = 1024; dst = (bf16_t*)(ws + WS_WD); ldd = 2816; nTn = 4; }
        transpose_strip(tile, src, N, dst, ldd, mapmode, ks, cs, t / nTn, t % nTn);
    }
    } else {
    prep_rows(P.in[1], P.in[21], (bf16_t*)(ws + WS_MEMN), 1024);
    prep_rows(P.in[0], P.in[2], (bf16_t*)(ws + WS_R0), T_TOK);
    }
    }
}

__device__ __forceinline__ int zt_off(int d, int s) { return d * 256 + ((((s >> 3) ^ ((d & 15) ^ (d >> 4))) & 15) << 4) + (s & 7) * 2; }
__device__ __forceinline__ void phase_sgu(const Params& P, LAS unsigned char* lds) {
    unsigned char* ws = P.ws; int tid = threadIdx.x; asm volatile("" : "+v"(tid)); const int wid = tid >> 6, lane = tid & 63, fr = lane & 15, fq = lane >> 4;
    const bf16_t* ZU = (const bf16_t*)(ws + WS_R1); const bf16_t* ZV = (const bf16_t*)(ws + WS_R2); bf16_t* YB = (bf16_t*)(ws + WS_R0);
    const bf16_t* SW = (const bf16_t*)(ws + WS_SW); const float* zst = (const float*)(ws + WS_STAT);
    const float* lng = P.in[13]; const float* lnb = P.in[14]; const float* bias = P.in[16];
    LAS float* st = (LAS float*)(lds + 65536);
    for (int chunk = blockIdx.x; chunk < 256; chunk += gridDim.x) {
        const int r0 = chunk * 128;
        __syncthreads();
        if (tid < 128) { const float s1 = zst[2 * (r0 + tid)], s2 = zst[2 * (r0 + tid) + 1]; const float mu = s1 * (1.0f / 1024.0f); const float var = fmaxf(s2 * (1.0f / 1024.0f) - mu * mu, 0.f);
            st[2 * tid] = mu; st[2 * tid + 1] = rsqrtf(var + EPSV); }
        __syncthreads();
        const int d8 = tid & 15, sp0 = tid >> 4, t = wid * 16 + fr;
        u32x4 zv[2][2], zu[4]; bf16x8 wf[4]; f32x4 lg0, lg1, lb0, lb1; float bt;
#define SGU_LOAD(hh) do { \
            _Pragma("unroll") for (int it = 0; it < 2; ++it) { const int s0 = (sp0 + 32 * it) * 2; \
                zv[it][0] = *(const u32x4*)(ZV + (size_t)(r0 + s0) * 1024 + (hh) * 128 + d8 * 8); zv[it][1] = *(const u32x4*)(ZV + (size_t)(r0 + s0 + 1) * 1024 + (hh) * 128 + d8 * 8); } \
            _Pragma("unroll") for (int kk = 0; kk < 4; ++kk) wf[kk] = *(const bf16x8*)(SW + (size_t)((hh) * 128 + t) * 128 + kk * 32 + fq * 8); \
            _Pragma("unroll") for (int q = 0; q < 4; ++q) zu[q] = *(const u32x4*)(ZU + (size_t)(r0 + t) * 1024 + (hh) * 128 + q * 32 + fq * 8); \
            lg0 = *(const f32x4*)(lng + (hh) * 128 + d8 * 8); lg1 = *(const f32x4*)(lng + (hh) * 128 + d8 * 8 + 4); lb0 = *(const f32x4*)(lnb + (hh) * 128 + d8 * 8); lb1 = *(const f32x4*)(lnb + (hh) * 128 + d8 * 8 + 4); \
            bt = bias[(hh) * 128 + t]; } while (0)
        SGU_LOAD(0);
#pragma unroll 1
        for (int h = 0; h < 8; ++h) {
            LAS unsigned char* zt = lds + (h & 1) * 32768;
#pragma unroll
            for (int it = 0; it < 2; ++it) {
                const int s0 = (sp0 + 32 * it) * 2;
                f32x4 a0, b0, a1, b1; unpack8(zv[it][0], a0, b0); unpack8(zv[it][1], a1, b1);
                const float mu0 = st[2 * s0], rs0 = st[2 * s0 + 1], mu1 = st[2 * s0 + 2], rs1 = st[2 * s0 + 3];
                a0 = (a0 - mu0) * rs0 * lg0 + lb0; b0 = (b0 - mu0) * rs0 * lg1 + lb1; a1 = (a1 - mu1) * rs1 * lg0 + lb0; b1 = (b1 - mu1) * rs1 * lg1 + lb1;
#pragma unroll
                for (int j = 0; j < 4; ++j) {
                    *(LAS unsigned*)(zt + zt_off(d8 * 8 + j, s0)) = cvt_pk_bf16(a0[j], a1[j]);
                    *(LAS unsigned*)(zt + zt_off(d8 * 8 + 4 + j, s0)) = cvt_pk_bf16(b0[j], b1[j]);
                }
            }
            bf16x8 wfc[4]; u32x4 zuc[4]; const float btc = bt;
#pragma unroll
            for (int kk = 0; kk < 4; ++kk) { wfc[kk] = wf[kk]; zuc[kk] = zu[kk]; }
            if (h < 7) SGU_LOAD(h + 1);
            __syncthreads();
#pragma unroll
            for (int q = 0; q < 4; ++q) {
                f32x4 acc0 = (f32x4){0.f, 0.f, 0.f, 0.f}, acc1 = (f32x4){0.f, 0.f, 0.f, 0.f};
                const int drow = 32 * q + 8 * (fr >> 2) + (fr & 3);
#pragma unroll
                for (int kk = 0; kk < 4; ++kk) {
                    const bf16x8 z0 = *(const LAS bf16x8*)(zt + zt_off(drow, kk * 32 + fq * 8)), z1 = *(const LAS bf16x8*)(zt + zt_off(drow + 4, kk * 32 + fq * 8));
                    acc0 = __builtin_amdgcn_mfma_f32_16x16x32_bf16(z0, wfc[kk], acc0, 0, 0, 0); acc1 = __builtin_amdgcn_mfma_f32_16x16x32_bf16(z1, wfc[kk], acc1, 0, 0, 0); }
                f32x4 za, zb; unpack8(zuc[q], za, zb);
                *(u32x4*)(YB + (size_t)(r0 + t) * 1024 + h * 128 + q * 32 + fq * 8) = pack8(za * (acc0 + btc), zb * (acc1 + btc));
            }
        }
#undef SGU_LOAD
    }
    __syncthreads();
}

__device__ __forceinline__ void scan_item(const Params& P, LAS unsigned char* lds, int gg, int b) {
    unsigned char* ws = P.ws; int tid = threadIdx.x; asm volatile("" : "+v"(tid)); const int wid = tid >> 6, p = tid & 63;
    const float* SEND = (const float*)(ws + WS_SEND); bf16_t* A5 = (bf16_t*)(ws + WS_A5);
    LAS float* le = (LAS float*)lds;
    const double INV2PI = 0.15915494309189533577;
    const size_t rowb = (size_t)gg * 1024 + b * 256;
#pragma unroll 1
    for (int dir = 0; dir < 2; ++dir) {
        const int q = (dir * 32 + gg) * 64 + p;
        const float step = expf(P.in[6][dir * 32 + gg]); const float zr = P.in[4][q] * step; const double zi = (double)P.in[5][q] * (double)step;
        float c, s; cis_rev(zi * 32.0 * INV2PI, c, s); float mag = expf(32.0f * zr); const float l32r = mag * c, l32i = mag * s;
        cis_rev(zi * 1024.0 * INV2PI, c, s); mag = expf(1024.0f * zr); const float lWr = mag * c, lWi = mag * s;
        const int k0 = dir ? 255 - wid * 32 : wid * 32; const long sstride = dir ? -256 : 256, dstride = dir ? -768 : 768;
        const float* srcp = SEND + (rowb + k0) * 256 + dir * 128 + p; bf16_t* dstp = A5 + (rowb + k0) * 768 + 512 + dir * 128 + p;
        float sr[32], si[32];
#pragma unroll
        for (int i = 0; i < 32; ++i) { sr[i] = srcp[0]; si[i] = srcp[64]; srcp += sstride; asm volatile("" : "+v"(srcp)); }
        float cr = 0.f, ci = 0.f;
#pragma unroll
        for (int i = 0; i < 32; ++i) { const float nr = l32r * cr - l32i * ci + sr[i], ni = l32r * ci + l32i * cr + si[i]; cr = nr; ci = ni; }
        __syncthreads();
        le[(wid * 64 + p) * 2] = cr; le[(wid * 64 + p) * 2 + 1] = ci;
        __syncthreads();
        cr = 0.f; ci = 0.f;
        for (int v = 0; v < wid; ++v) { const float er = le[(v * 64 + p) * 2], ei = le[(v * 64 + p) * 2 + 1]; const float nr = lWr * cr - lWi * ci + er, ni = lWr * ci + lWi * cr + ei; cr = nr; ci = ni; }
#pragma unroll
        for (int i = 0; i < 32; ++i) {
            dstp[0] = (bf16_t)(cvt_pk_bf16(cr, 0.f) & 0xffffu); dstp[64] = (bf16_t)(cvt_pk_bf16(ci, 0.f) & 0xffffu); dstp += dstride; asm volatile("" : "+v"(dstp));
            const float nr = l32r * cr - l32i * ci + sr[i], ni = l32r * ci + l32i * cr + si[i]; cr = nr; ci = ni;
        }
    }
    asm volatile("s_waitcnt vmcnt(0)" ::: "memory");
    __syncthreads();
}

__device__ __forceinline__ void phase_softmax(const Params& P) {
    const float* S = P.out; bf16_t* Pm = (bf16_t*)(P.ws + WS_R3);
    int tidl = threadIdx.x; asm volatile("" : "+v"(tidl)); const int wid = tidl >> 6, lane = tidl & 63;
    for (int row0 = (blockIdx.x * 8 + wid) * 8; row0 < T_TOK * 4; row0 += gridDim.x * 64) {
        f32x4 v[8];
#pragma unroll
        for (int rr = 0; rr < 8; ++rr) v[rr] = __builtin_nontemporal_load((const f32x4*)(S + (size_t)(row0 + rr) * 256 + lane * 4));
#pragma unroll
        for (int rr = 0; rr < 8; ++rr) {
            const float mx = wave_max(fmaxf(fmaxf(v[rr][0], v[rr][1]), fmaxf(v[rr][2], v[rr][3])));
            f32x4 e; e[0] = __expf(v[rr][0] - mx); e[1] = __expf(v[rr][1] - mx); e[2] = __expf(v[rr][2] - mx); e[3] = __expf(v[rr][3] - mx);
            const float sum = wave_sum(e[0] + e[1] + e[2] + e[3]); const float inv = 1.0f / sum;
            u32x2 w; w.x = cvt_pk_bf16(e[0] * inv, e[1] * inv); w.y = cvt_pk_bf16(e[2] * inv, e[3] * inv);
            *(u32x2*)(Pm + (size_t)(row0 + rr) * 256 + lane * 4) = w;
        }
    }
}

__device__ __forceinline__ void phase_final(const Params& P) {
    float* out = P.out; const float* ss = (const float*)(P.ws + WS_STAT) + 4 * T_TOK; const float* gn = P.in[30]; const bf16_t* H = (const bf16_t*)(P.ws + WS_R1);
    int tidl = threadIdx.x; asm volatile("" : "+v"(tidl)); const int wid = tidl >> 6, lane = tidl & 63;
    f32x4 g4[4];
#pragma unroll
    for (int j = 0; j < 4; ++j) g4[j] = *(const f32x4*)(gn + j * 256 + lane * 4);
    for (int row0 = (blockIdx.x * 8 + wid) * 8; row0 < T_TOK; row0 += gridDim.x * 64) {
        u32x2 v[8][4]; float rs[8];
#pragma unroll
        for (int rr = 0; rr < 8; ++rr) { rs[rr] = ss[row0 + rr];
#pragma unroll
            for (int j = 0; j < 4; ++j) v[rr][j] = __builtin_nontemporal_load((const u32x2*)(H + (size_t)(row0 + rr) * 1024 + j * 256 + lane * 4)); }
#pragma unroll
        for (int rr = 0; rr < 8; ++rr) { const float r1 = rsqrtf(rs[rr] * (1.0f / 1024.0f) + EPSV);
#pragma unroll
            for (int j = 0; j < 4; ++j) { const f32x4 a = (f32x4){bflo(v[rr][j].x), bfhi(v[rr][j].x), bflo(v[rr][j].y), bfhi(v[rr][j].y)};
                __builtin_nontemporal_store(a * r1 * g4[j], (f32x4*)(out + (size_t)(row0 + rr) * 1024 + j * 256 + lane * 4)); } }
    }
}

#define XB_TMO      128
#define XB_XCNT(j)  (256  + 64 * (j))
#define XB_XSUB(j)  (1280 + 64 * (j))
#define XB_XGEN(j)  (2304 + 64 * (j))
#define XB_TOP      3328
#define XB_TOPGEN   3392
#define XB_LSUB(j)  (3520 + 64 * (j))
#define XB_LGEN(j)  (4544 + 64 * (j))
#define XCD_BAR_WORDS 5568
#define XB_SPIN_CAP (1u << 20)
__device__ __forceinline__ unsigned xb_ld(unsigned* p)              { return __hip_atomic_load(p, __ATOMIC_RELAXED, __HIP_MEMORY_SCOPE_AGENT); }
__device__ __forceinline__ unsigned xb_add(unsigned* p, unsigned v) { return __hip_atomic_fetch_add(p, v, __ATOMIC_RELAXED, __HIP_MEMORY_SCOPE_AGENT); }
__device__ __forceinline__ unsigned xb_xcc_id() { return (unsigned)__builtin_amdgcn_s_getreg((3 << 11) | 20) & 0xFu; }
#define XB_SPIN(cond, bar) do { unsigned _sp = 0; while (cond) { __builtin_amdgcn_s_sleep(1); \
    if ((++_sp & 255u) == 0u) { if (xb_ld(&(bar)[XB_TMO])) break; if (_sp > XB_SPIN_CAP) { atomicAdd(&(bar)[XB_TMO], 1u); break; } } } } while (0)
struct XcdBarrier { unsigned* bar; unsigned x; volatile LAS unsigned* st; };
__device__ __forceinline__ XcdBarrier xcd_barrier_post(unsigned* bar, volatile LAS unsigned* st) {
    XcdBarrier b; b.bar = bar; b.x = xb_xcc_id(); b.st = st;
    if (threadIdx.x == 0) st[2] = xb_add(&bar[XB_XCNT(b.x)], 1u);
    return b;
}
__device__ __forceinline__ void xcd_barrier_complete(unsigned* bar, unsigned x, unsigned& nloc, unsigned& nx, unsigned& info) {
    const unsigned G = gridDim.x * gridDim.y * gridDim.z;
    unsigned sum, cnt, mine, sp = 0u, bad, xd;
    for (;;) {
        sum = 0u; cnt = 0u; mine = 0u; bad = 0u; xd = 0u;
#pragma unroll
        for (unsigned j = 0; j < 16; ++j) { const unsigned c = xb_ld(&bar[XB_XCNT(j)]); sum += c; cnt += (c > 0u) ? 1u : 0u; mine = (j == x) ? c : mine; bad += (c != 0u && c != 32u) ? 1u : 0u; xd += (c > 0u && j < x) ? 1u : 0u; }
        if (sum == G) break;
        __builtin_amdgcn_s_sleep(1);
        if ((++sp & 255u) == 0u) { if (xb_ld(&bar[XB_TMO])) break; if (sp > XB_SPIN_CAP) { atomicAdd(&bar[XB_TMO], 1u); break; } }
    }
    nloc = mine > 0u ? mine : 1u; nx = cnt > 0u ? cnt : 1u;
    info = (sum == G && G == 256u && cnt == 8u && bad == 0u) ? (0x100u | xd) : 0u;
}
__device__ __forceinline__ void xcd_barrier(const XcdBarrier& b) {
    asm volatile("s_waitcnt vmcnt(0)" ::: "memory");
    __syncthreads();
    if (threadIdx.x == 0) {
        unsigned* bar = b.bar;
        __builtin_amdgcn_s_waitcnt(0);
        unsigned nloc = b.st[0], nx = b.st[1];
        if (nloc == 0u) { unsigned info; xcd_barrier_complete(bar, b.x, nloc, nx, info); b.st[0] = nloc; b.st[1] = nx; b.st[3] = info; }
        const unsigned old = xb_add(&bar[XB_XSUB(b.x)], 1u);
        const unsigned gen = old / nloc;
        if (old + 1u == (gen + 1u) * nloc) {
            __builtin_amdgcn_fence(__ATOMIC_RELEASE, "agent");
            asm volatile("s_waitcnt vmcnt(0)" ::: "memory");
            const unsigned og = xb_add(&bar[XB_TOP], 1u);
            const unsigned tg = og / nx;
            if (og + 1u == (tg + 1u) * nx) xb_add(&bar[XB_TOPGEN], 1u);
            else XB_SPIN(xb_ld(&bar[XB_TOPGEN]) == tg, bar);
            __builtin_amdgcn_fence(__ATOMIC_ACQUIRE, "agent");
            xb_add(&bar[XB_XGEN(b.x)], 1u);
            asm volatile("s_waitcnt vmcnt(0)" ::: "memory");
        } else {
            XB_SPIN(xb_ld(&bar[XB_XGEN(b.x)]) == gen, bar);
            __builtin_amdgcn_fence(__ATOMIC_ACQUIRE, "agent");
            asm volatile("s_waitcnt vmcnt(0)" ::: "memory");
        }
    }
    __syncthreads();
}

__device__ __forceinline__ void loc_barrier(const XcdBarrier& b, bool loc) {
    if (!loc) { xcd_barrier(b); return; }
    asm volatile("s_waitcnt vmcnt(0)" ::: "memory");
    __syncthreads();
    if (threadIdx.x == 0) {
        unsigned* bar = b.bar;
        __builtin_amdgcn_s_waitcnt(0);
        const unsigned nloc = b.st[0];
        const unsigned old = xb_add(&bar[XB_LSUB(b.x)], 1u);
        const unsigned gen = old / nloc;
        if (old + 1u == (gen + 1u) * nloc) xb_add(&bar[XB_LGEN(b.x)], 1u);
        else XB_SPIN(xb_ld(&bar[XB_LGEN(b.x)]) == gen, bar);
        __builtin_amdgcn_fence(__ATOMIC_ACQUIRE, "agent");
        asm volatile("s_waitcnt vmcnt(0)" ::: "memory");
    }
    __syncthreads();
}

__global__ void __launch_bounds__(512, 2) mega_fwd(Params P) {
    extern __shared__ __attribute__((aligned(16))) unsigned char shm[];
    LAS unsigned char* lds = (LAS unsigned char*)shm;
    cg::grid_group grid = cg::this_grid();
    volatile LAS unsigned* xst = (volatile LAS unsigned*)(lds + 131072);
    if (threadIdx.x == 0) { xst[0] = 0u; xst[1] = 0u; xst[2] = 0u; xst[3] = 0u; }
    __syncthreads();
    XcdBarrier xb = xcd_barrier_post((unsigned*)(P.ws + WS_BAR), xst);
#define RUNG(MODE, ID) do { GemmArgs ga; make_gemm(P, ID, ga); gemm_phase<MODE>(P, lds, ga); } while (0)
#define RUNL(MODE, ID) do { GemmArgs ga; make_gemm(P, ID, ga); ga.cv = cv; gemm_phase<MODE>(P, lds, ga); } while (0)
    if (P.ws == nullptr) grid.sync();
    phase_prep(P, lds); xcd_barrier(xb);
    const unsigned linfo = (unsigned)__builtin_amdgcn_readfirstlane((int)xst[3]); const bool loc = linfo != 0u;
    const int cv = loc ? (int)((unsigned)__builtin_amdgcn_readfirstlane((int)xst[2]) * 8u + (linfo & 0xffu)) : -1;
    RUNG(M_P1, G_P1); xcd_barrier(xb);
    RUNG(M_F32, G_S5E); RUNG(M_BF16, G_K); RUNG(M_BF16, G_VT); phase_sgu(P, lds); xcd_barrier(xb);
    {
        GemmArgs gy; make_gemm(P, G_S5Y, gy);
        for (int i = 0; i * (int)gridDim.x + (int)blockIdx.x < 256; ++i) {
            const int w = i * (int)gridDim.x + (int)blockIdx.x;
            scan_item(P, lds, w >> 3, w & 3);
            gy.i0 = i; gy.i1 = i + 1; gemm_phase<M_S5Y>(P, lds, gy);
        }
    }
    RUNG(M_MUL, G_PB); xcd_barrier(xb);
    RUNL(M_GLU, G_GLU); loc_barrier(xb, loc);
    RUNL(M_MULADD, G_PA); loc_barrier(xb, loc);
    RUNL(M_RESX, G_OUT); loc_barrier(xb, loc);
    {
        GemmArgs gq, gs, gp; make_gemm(P, G_Q, gq); make_gemm(P, G_SC, gs); make_gemm(P, G_PV, gp);
        gq.sched = SCH_QATT; gq.nunits = 512; gq.cv = cv; gs.cv = cv; gp.cv = cv;
        gemm_phase<M_ROWSCALE>(P, lds, gq);
        gemm_phase<M_SM>(P, lds, gs);
        gemm_phase<M_BF16>(P, lds, gp);
    }
    loc_barrier(xb, loc);
    RUNL(M_RES, G_XO); xcd_barrier(xb);
    RUNL(M_GU, G_GU); loc_barrier(xb, loc);
    RUNL(M_RES, G_DN); xcd_barrier(xb);
    phase_final(P);
#undef RUNG
#undef RUNL
}

extern "C" void kernel_launch(void* const* d_in, const int* in_sizes, int n_in, void* d_out, int out_size, void* d_ws, size_t ws_size, hipStream_t stream) {
    constexpr size_t kDynLds = 131072 + 16 + 8192;
    static int grid_blocks = 0;
    if (!grid_blocks) {
        int dev = 0, cus = 0, per_cu = 0;
        hipGetDevice(&dev);
        hipDeviceGetAttribute(&cus, hipDeviceAttributeMultiprocessorCount, dev);
        hipFuncSetAttribute((const void*)mega_fwd, hipFuncAttributeMaxDynamicSharedMemorySize, (int)kDynLds);
        hipOccupancyMaxActiveBlocksPerMultiprocessor(&per_cu, (const void*)mega_fwd, 512, kDynLds);
        if (per_cu < 1) per_cu = 1;
        grid_blocks = cus * per_cu;
        if (ws_size < WS_END) fprintf(stderr, "workspace too small: %zu < %zu\n", ws_size, (size_t)WS_END);
    }
    Params p{};
    for (int i = 0; i < 31; ++i) p.in[i] = (const float*)d_in[i];
    p.out = (float*)d_out; p.ws = (unsigned char*)d_ws;
    (void)hipMemsetAsync((unsigned char*)d_ws + WS_BAR, 0, XCD_BAR_WORDS * 4, stream);
    void* args[] = {&p};
    hipError_t e = hipLaunchCooperativeKernel((const void*)mega_fwd, dim3(grid_blocks), dim3(512), args, kDynLds, stream);
    if (e != hipSuccess) fprintf(stderr, "cooperative launch failed: %s (grid %d)\n", hipGetErrorString(e), grid_blocks);
}
```

```cpp
#include <hip/hip_runtime.h>
#include <hip/hip_cooperative_groups.h>
#include <cstdio>
namespace cg = cooperative_groups;

#define LAS __attribute__((address_space(3)))
typedef unsigned short bf16_t;
typedef short bf16x8 __attribute__((ext_vector_type(8)));
typedef float f32x4 __attribute__((ext_vector_type(4)));
typedef unsigned u32x4 __attribute__((ext_vector_type(4)));
typedef unsigned u32x2 __attribute__((ext_vector_type(2)));

constexpr int T_TOK = 32768, DM = 1024, DFF = 2816;
constexpr float EPSV = 1e-6f;
constexpr size_t MiB = 1048576;
constexpr size_t WS_WIN = 0, WS_WGLU = 9 * MiB, WS_WPA = WS_WGLU + MiB / 2, WS_WPB = WS_WPA + MiB, WS_WOUT = WS_WPB + 2 * MiB,
                 WS_WQ = WS_WOUT + 2 * MiB, WS_WK = WS_WQ + 2 * MiB, WS_WV = WS_WK + 2 * MiB, WS_WXO = WS_WV + 2 * MiB,
                 WS_WGU = WS_WXO + 2 * MiB, WS_WD = WS_WGU + 11 * MiB, WS_SW = WS_WD + 6 * MiB, WS_MEMN = WS_SW + MiB,
                 WS_KB = WS_MEMN + 2 * MiB, WS_VT = WS_KB + 2 * MiB, WS_B5 = WS_VT + 2 * MiB, WS_SEND = WS_B5 + 36 * MiB,
                 WS_STAT = WS_SEND + 32 * MiB, WS_A5 = WS_STAT + MiB, WS_R0 = WS_A5 + 48 * MiB, WS_R1 = WS_R0 + 64 * MiB,
                 WS_R2 = WS_R1 + 64 * MiB, WS_R3 = WS_R2 + 64 * MiB, WS_R4 = WS_R3 + 64 * MiB, WS_END = WS_R4 + 64 * MiB;
constexpr size_t WS_BAR = WS_STAT + 768 * 1024;
static_assert(WS_END <= 512 * MiB, "workspace");

struct Params { const float* in[31]; float* out; unsigned char* ws; };

__device__ __forceinline__ unsigned cvt_pk_bf16(float lo, float hi) { unsigned r; asm volatile("v_cvt_pk_bf16_f32 %0, %1, %2" : "=v"(r) : "v"(lo), "v"(hi)); return r; }
__device__ __forceinline__ float bflo(unsigned w) { return __uint_as_float(w << 16); }
__device__ __forceinline__ float bfhi(unsigned w) { return __uint_as_float(w & 0xffff0000u); }
__device__ __forceinline__ float fsigmoid(float x) { return __builtin_amdgcn_rcpf(1.0f + __expf(-x)); }
__device__ __forceinline__ float fgelu(float x) { const float u = 1.5957691216f * (x + 0.044715f * x * x * x); return x * fsigmoid(u); }
__device__ __forceinline__ f32x4 vsigmoid4(const f32x4 x) { const f32x4 t = x * (-1.4426950409f); f32x4 e; e[0] = __builtin_amdgcn_exp2f(t[0]); e[1] = __builtin_amdgcn_exp2f(t[1]); e[2] = __builtin_amdgcn_exp2f(t[2]); e[3] = __builtin_amdgcn_exp2f(t[3]);
    const f32x4 d = e + 1.0f; f32x4 r; r[0] = __builtin_amdgcn_rcpf(d[0]); r[1] = __builtin_amdgcn_rcpf(d[1]); r[2] = __builtin_amdgcn_rcpf(d[2]); r[3] = __builtin_amdgcn_rcpf(d[3]); return r; }
__device__ __forceinline__ f32x4 vgelu4(const f32x4 x) { const f32x4 x2 = x * x; const f32x4 t = x * (x2 * (-1.5957691216f * 0.044715f * 1.4426950409f) + (-1.5957691216f * 1.4426950409f));
    f32x4 e; e[0] = __builtin_amdgcn_exp2f(t[0]); e[1] = __builtin_amdgcn_exp2f(t[1]); e[2] = __builtin_amdgcn_exp2f(t[2]); e[3] = __builtin_amdgcn_exp2f(t[3]);
    const f32x4 d = e + 1.0f; f32x4 r; r[0] = __builtin_amdgcn_rcpf(d[0]); r[1] = __builtin_amdgcn_rcpf(d[1]); r[2] = __builtin_amdgcn_rcpf(d[2]); r[3] = __builtin_amdgcn_rcpf(d[3]); return x * r; }
__device__ __forceinline__ float wave_sum(float v) { v += __shfl_xor(v, 32); v += __shfl_xor(v, 16); v += __shfl_xor(v, 8); v += __shfl_xor(v, 4); v += __shfl_xor(v, 2); v += __shfl_xor(v, 1); return v; }
__device__ __forceinline__ float wave_max(float v) { v = fmaxf(v, __shfl_xor(v, 32)); v = fmaxf(v, __shfl_xor(v, 16)); v = fmaxf(v, __shfl_xor(v, 8)); v = fmaxf(v, __shfl_xor(v, 4)); v = fmaxf(v, __shfl_xor(v, 2)); v = fmaxf(v, __shfl_xor(v, 1)); return v; }
__device__ __forceinline__ u32x4 pack8(const f32x4 a, const f32x4 b) { u32x4 w; w.x = cvt_pk_bf16(a[0], a[1]); w.y = cvt_pk_bf16(a[2], a[3]); w.z = cvt_pk_bf16(b[0], b[1]); w.w = cvt_pk_bf16(b[2], b[3]); return w; }
__device__ __forceinline__ void unpack8(const u32x4 w, f32x4& a, f32x4& b) { a = (f32x4){bflo(w.x), bfhi(w.x), bflo(w.y), bfhi(w.y)}; b = (f32x4){bflo(w.z), bfhi(w.z), bflo(w.w), bfhi(w.w)}; }
__device__ __forceinline__ void cis_rev(double rev, float& c, float& s) { rev -= rint(rev); const float f = (float)rev; c = __builtin_amdgcn_cosf(f); s = __builtin_amdgcn_sinf(f); }

constexpr int BM = 256, BK = 64, HALF = 128, HTB = HALF * BK * 2, NXCD = 8, WGM = 8;
__device__ __forceinline__ int lds_byte(int r, int c) { const int st = (r >> 4) * 2 + (c >> 5), rr = r & 15, cc = c & 31, ob = rr * 64 + cc * 2; return st * 1024 + (ob ^ (((ob >> 9) & 1) << 5)); }
__device__ __forceinline__ void stage_rc(int b, int& R, int& C) { const int st = b / 1024, sb = b % 1024, swz = sb ^ (((sb >> 9) & 1) << 5); R = (st >> 1) * 16 + swz / 64; C = (st & 1) * 32 + (swz % 64) / 2; }
__device__ __forceinline__ int perm32(int rho) { const int n = rho >> 4, i = rho & 15; return 8 * (i >> 2) + 4 * n + (i & 3); }

enum { SCH_STD = 0, SCH_S5Y, SCH_S5E, SCH_ATT_S, SCH_ATT_PV, SCH_QATT };
enum { M_P1 = 0, M_F32, M_BF16, M_MULADD, M_S5Y, M_GLU, M_RES, M_ROWSCALE, M_GU, M_SM, M_MUL, M_RESX };
enum { G_P1 = 0, G_S5E, G_K, G_VT, G_PB, G_S5Y, G_GLU, G_PA, G_OUT, G_Q, G_SC, G_PV, G_XO, G_GU, G_DN };

struct Unit { int pm, pn; size_t ao, bo; };
struct GemmArgs {
    const bf16_t* A; const bf16_t* Bt; int lda, ldb, K, perm, mode, sched, nM, nN, nunits, shift, ldc, i0, i1, rev, cv, wgm;
    void* C; const void* X1; const void* X2; float* F1; bf16_t* H;
};

__device__ __forceinline__ bool sched_next(const GemmArgs& g, int G, int c, int i, Unit& u) {
    if (i >= g.i1) return false;
    const int nr = g.nunits / G; const int ii = (g.rev && nr * G == g.nunits) ? (i < nr ? nr - 1 - i : i) : i;
    const long L = (long)ii * G + c; if (L >= g.nunits) return false;
    int w = (int)L;
    if (g.sched == SCH_QATT || g.sched == SCH_ATT_S || g.sched == SCH_ATT_PV) {
        const int nwg = 512; { const int q = nwg / NXCD, xcd = w % NXCD, off = w / NXCD; w = xcd * q + off; }
        const int pmx = (w >> 5) * 8 + (w & 7), hx = (w & 31) >> 3; w = pmx * 4 + hx;
    }
    if (g.sched == SCH_STD) {
        const int nwg = g.nunits, nN = g.nN, nM = g.nM;
        { const int q = nwg / NXCD, r = nwg % NXCD, xcd = w % NXCD, off = w / NXCD; w = (xcd < r ? xcd * (q + 1) : r * (q + 1) + (xcd - r) * q) + off; }
        const int wgm = g.wgm; const int nig = wgm * nN, gid = w / nig, fm = gid * wgm, gsz = (nM - fm) < wgm ? (nM - fm) : wgm;
        u.pm = fm + ((w % nig) % gsz); u.pn = (w % nig) / gsz;
        u.ao = (size_t)u.pm * 256 * g.lda * 2; u.bo = (size_t)u.pn * 256 * g.ldb * 2;
    } else if (g.sched == SCH_S5Y) {
        const int gg = w >> 3, pml = w & 3, pnl = (w >> 2) & 1;
        u.pm = gg * 4 + pml; u.pn = pnl; u.ao = (size_t)u.pm * 256 * 768 * 2; u.bo = (size_t)(gg * 768 + pnl * 256) * 768 * 2;
    } else if (g.sched == SCH_S5E) {
        const int gg = w >> 2, pml = w & 3;
        u.pm = gg * 4 + pml; u.pn = 0; u.ao = (size_t)u.pm * 256 * 768 * 2; u.bo = (size_t)(gg * 768 + 512) * 768 * 2;
    } else if (g.sched == SCH_QATT) {
        const int pm = w >> 2, h = w & 3;
        u.pm = pm; u.pn = h; u.ao = (size_t)pm * 256 * 1024 * 2; u.bo = (size_t)h * 256 * 1024 * 2;
    } else if (g.sched == SCH_ATT_S) {
        const int pm = w >> 2, h = w & 3;
        u.pm = pm; u.pn = h; u.ao = ((size_t)pm * 256 * 1024 + h * 256) * 2; u.bo = ((size_t)(pm >> 5) * 256 * 1024 + h * 256) * 2;
    } else {
        const int pm = w >> 2, h = w & 3;
        u.pm = pm; u.pn = h; u.ao = ((size_t)pm * 256 * 1024 + h * 256) * 2; u.bo = ((size_t)h * 256 * 1024 + (pm >> 5) * 256) * 2;
    }
    return true;
}

template <int ACT> __device__ __forceinline__ void p1_epi(const f32x4 (&acc)[2][2][4][2], bf16_t* base, int coff, float* zst, int pn, int rbase, int wc, int fq) {
#pragma unroll
    for (int ai = 0; ai < 2; ++ai)
#pragma unroll
        for (int m = 0; m < 4; ++m) {
            const int r = rbase + ai * 128 + m * 16; float s1 = 0.f, s2 = 0.f;
#pragma unroll
            for (int bj = 0; bj < 2; ++bj) {
                const int c = pn * 256 + wc * 64 + bj * 32 + 8 * fq;
                f32x4 v0 = acc[ai][bj][m][0], v1 = acc[ai][bj][m][1];
                bf16_t* dst;
                if (ACT == 0) dst = base + ((size_t)((c >> 4) * 1024 + (r >> 5)) * 768 + (r & 31) * 16 + (c & 15));
                else dst = base + (size_t)r * 1024 + (c - coff);
                if (ACT == 1 || ACT == 2) { v0 = vgelu4(v0); v1 = vgelu4(v1);
                    if (ACT == 2) { const f32x4 sa = v0 + v1, sb = v0 * v0 + v1 * v1; s1 += (sa[0] + sa[1]) + (sa[2] + sa[3]); s2 += (sb[0] + sb[1]) + (sb[2] + sb[3]); } }
                else if (ACT == 3) { v0 = vsigmoid4(v0); v1 = vsigmoid4(v1); }
                __builtin_nontemporal_store(pack8(v0, v1), (u32x4*)dst);
            }
            if (ACT == 2) {
                s1 += __shfl_xor(s1, 16); s1 += __shfl_xor(s1, 32); s2 += __shfl_xor(s2, 16); s2 += __shfl_xor(s2, 32);
                if (fq == 0) { atomicAdd(zst + 2 * r, s1); atomicAdd(zst + 2 * r + 1, s2); }
            }
        }
}

template <int MODE> __device__ __forceinline__ void epilogue(const Params& P, const GemmArgs& g, f32x4 (&acc)[2][2][4][2], const Unit& u, int wr, int wc, int fr, int fq, LAS unsigned char* lds, const float (&ssp)[2][4]) {
    const int rbase = u.pm * 256 + wr * 64 + fr;
    unsigned char* ws = P.ws;
    switch (MODE) {
    case M_P1: {
        const int reg = u.pn;
        if (reg < 2) p1_epi<0>(acc, (bf16_t*)(ws + WS_A5), 0, nullptr, u.pn, rbase, wc, fq);
        else if (reg < 6) p1_epi<1>(acc, (bf16_t*)(ws + WS_R1), 512, nullptr, u.pn, rbase, wc, fq);
        else if (reg < 10) p1_epi<2>(acc, (bf16_t*)(ws + WS_R2), 1536, (float*)(ws + WS_STAT), u.pn, rbase, wc, fq);
        else if (reg < 14) p1_epi<3>(acc, (bf16_t*)(ws + WS_R3), 2560, nullptr, u.pn, rbase, wc, fq);
        else p1_epi<3>(acc, (bf16_t*)(ws + WS_R4), 3584, nullptr, u.pn, rbase, wc, fq);
    } break;
    case M_F32: {
        float* C = (float*)g.C;
#pragma unroll
        for (int ai = 0; ai < 2; ++ai)
#pragma unroll
            for (int m = 0; m < 4; ++m) {
                float* rowp = C + (size_t)(rbase + ai * 128 + m * 16) * g.ldc + u.pn * 256 + wc * 64 + 8 * fq;
#pragma unroll
                for (int bj = 0; bj < 2; ++bj)
#pragma unroll
                    for (int n = 0; n < 2; ++n) *(f32x4*)(rowp + bj * 32 + n * 4) = acc[ai][bj][m][n];
            }
    } break;
    case M_BF16: {
        bf16_t* C = (bf16_t*)g.C;
#pragma unroll
        for (int ai = 0; ai < 2; ++ai)
#pragma unroll
            for (int m = 0; m < 4; ++m) {
                bf16_t* rowp = C + (size_t)(rbase + ai * 128 + m * 16) * g.ldc + u.pn * 256 + wc * 64 + 8 * fq;
#pragma unroll
                for (int bj = 0; bj < 2; ++bj) *(u32x4*)(rowp + bj * 32) = pack8(acc[ai][bj][m][0], acc[ai][bj][m][1]);
            }
    } break;
    case M_MUL:
    case M_MULADD: {
        bf16_t* C = (bf16_t*)g.C; const bf16_t* X1 = (const bf16_t*)g.X1; const bf16_t* X2 = (const bf16_t*)g.X2;
#pragma unroll
        for (int ai = 0; ai < 2; ++ai) {
            u32x4 x1[4][2], x2[4][2];
#pragma unroll
            for (int m = 0; m < 4; ++m)
#pragma unroll
                for (int bj = 0; bj < 2; ++bj) { const size_t off = (size_t)(rbase + ai * 128 + m * 16) * 1024 + u.pn * 256 + wc * 64 + 8 * fq + bj * 32;
                    x1[m][bj] = *(const u32x4*)(X1 + off); if (MODE == M_MULADD) x2[m][bj] = *(const u32x4*)(X2 + off); }
#pragma unroll
            for (int m = 0; m < 4; ++m)
#pragma unroll
                for (int bj = 0; bj < 2; ++bj) { const size_t off = (size_t)(rbase + ai * 128 + m * 16) * 1024 + u.pn * 256 + wc * 64 + 8 * fq + bj * 32;
                    f32x4 a, b; unpack8(x1[m][bj], a, b);
                    f32x4 v0 = acc[ai][bj][m][0] * a, v1 = acc[ai][bj][m][1] * b;
                    if (MODE == M_MULADD) { f32x4 c2, d2; unpack8(x2[m][bj], c2, d2); v0 += c2; v1 += d2; }
                    *(u32x4*)(C + off) = pack8(v0, v1); }
        }
    } break;
    case M_S5Y: {
        bf16_t* C = (bf16_t*)g.C;
#pragma unroll
        for (int ai = 0; ai < 2; ++ai)
#pragma unroll
            for (int m = 0; m < 4; ++m) {
                const int r = rbase + ai * 128 + m * 16; const int gg = r >> 10, ml = r & 1023;
#pragma unroll
                for (int bj = 0; bj < 2; ++bj) {
                    const int n = u.pn * 256 + wc * 64 + bj * 32 + 8 * fq; const int t = n >> 4, co = n & 15;
                    f32x4 v0 = acc[ai][bj][m][0], v1 = acc[ai][bj][m][1];
                    v0 = vgelu4(v0); v1 = vgelu4(v1);
                    *(u32x4*)(C + (size_t)(ml * 32 + t) * 512 + gg * 16 + co) = pack8(v0, v1);
                }
            }
    } break;
    case M_GLU: {
        bf16_t* C = (bf16_t*)g.C; const bf16_t* X1 = (const bf16_t*)g.X1;
#pragma unroll
        for (int ai = 0; ai < 2; ++ai) {
            u32x4 x1[4][2];
#pragma unroll
            for (int m = 0; m < 4; ++m)
#pragma unroll
                for (int bj = 0; bj < 2; ++bj) x1[m][bj] = *(const u32x4*)(X1 + (size_t)(rbase + ai * 128 + m * 16) * 512 + u.pn * 256 + wc * 64 + 8 * fq + bj * 32);
#pragma unroll
            for (int m = 0; m < 4; ++m)
#pragma unroll
                for (int bj = 0; bj < 2; ++bj) {
                    f32x4 a, b; unpack8(x1[m][bj], a, b);
                    f32x4 v0 = acc[ai][bj][m][0], v1 = acc[ai][bj][m][1];
                    v0 = a * vsigmoid4(v0); v1 = b * vsigmoid4(v1);
                    *(u32x4*)(C + (size_t)(rbase + ai * 128 + m * 16) * 512 + u.pn * 256 + wc * 64 + 8 * fq + bj * 32) = pack8(v0, v1);
                }
        }
    } break;
    case M_RESX:
    case M_RES: {
        const float* R = (const float*)g.X1; bf16_t* H = g.H; float* ss = g.F1;
#pragma unroll
        for (int ai = 0; ai < 2; ++ai) {
            f32x4 ra[4][2], rb[4][2];
            if (MODE == M_RESX) {
#pragma unroll
                for (int m = 0; m < 4; ++m)
#pragma unroll
                    for (int bj = 0; bj < 2; ++bj) { const float* p = R + (size_t)(rbase + ai * 128 + m * 16) * 1024 + u.pn * 256 + wc * 64 + 8 * fq + bj * 32;
                        ra[m][bj] = __builtin_nontemporal_load((const f32x4*)p); rb[m][bj] = __builtin_nontemporal_load((const f32x4*)(p + 4)); }
            } else {
                u32x4 w[4][2];
#pragma unroll
                for (int m = 0; m < 4; ++m)
#pragma unroll
                    for (int bj = 0; bj < 2; ++bj) w[m][bj] = *(const u32x4*)(H + (size_t)(rbase + ai * 128 + m * 16) * 1024 + u.pn * 256 + wc * 64 + 8 * fq + bj * 32);
#pragma unroll
                for (int m = 0; m < 4; ++m)
#pragma unroll
                    for (int bj = 0; bj < 2; ++bj) unpack8(w[m][bj], ra[m][bj], rb[m][bj]);
            }
#pragma unroll
            for (int m = 0; m < 4; ++m) {
                const int r = rbase + ai * 128 + m * 16; float sq = 0.f;
#pragma unroll
                for (int bj = 0; bj < 2; ++bj) {
                    const f32x4 a = ra[m][bj] + acc[ai][bj][m][0], b = rb[m][bj] + acc[ai][bj][m][1];
                    sq += a[0] * a[0] + a[1] * a[1] + a[2] * a[2] + a[3] * a[3] + b[0] * b[0] + b[1] * b[1] + b[2] * b[2] + b[3] * b[3];
                    *(u32x4*)(H + (size_t)r * 1024 + u.pn * 256 + wc * 64 + 8 * fq + bj * 32) = pack8(a, b);
                }
                sq += __shfl_xor(sq, 16); sq += __shfl_xor(sq, 32);
                if (fq == 0) atomicAdd(ss + r, sq);
            }
        }
    } break;
    case M_ROWSCALE: {
        bf16_t* C = (bf16_t*)g.C; float ssv[2][4];
#pragma unroll
        for (int ai = 0; ai < 2; ++ai)
#pragma unroll
            for (int m = 0; m < 4; ++m) ssv[ai][m] = ssp[ai][m];
#pragma unroll
        for (int ai = 0; ai < 2; ++ai)
#pragma unroll
            for (int m = 0; m < 4; ++m) {
                const int r = rbase + ai * 128 + m * 16; const float rs = rsqrtf(ssv[ai][m] * (1.0f / 1024.0f) + EPSV);
                bf16_t* rowp = C + (size_t)r * 1024 + u.pn * 256 + wc * 64 + 8 * fq;
#pragma unroll
                for (int bj = 0; bj < 2; ++bj) *(u32x4*)(rowp + bj * 32) = pack8(acc[ai][bj][m][0] * rs, acc[ai][bj][m][1] * rs);
            }
    } break;
    case M_GU: {
        bf16_t* C = (bf16_t*)g.C; float ssv[2][4];
#pragma unroll
        for (int ai = 0; ai < 2; ++ai)
#pragma unroll
            for (int m = 0; m < 4; ++m) ssv[ai][m] = ssp[ai][m];
#pragma unroll
        for (int ai = 0; ai < 2; ++ai)
#pragma unroll
            for (int m = 0; m < 4; ++m) {
                const int r = rbase + ai * 128 + m * 16; const float rs = rsqrtf(ssv[ai][m] * (1.0f / 1024.0f) + EPSV);
                const f32x4 g0 = acc[ai][0][m][0] * rs, g1 = acc[ai][0][m][1] * rs;
                const f32x4 v0 = g0 * vsigmoid4(g0) * (acc[ai][1][m][0] * rs), v1 = g1 * vsigmoid4(g1) * (acc[ai][1][m][1] * rs);
                __builtin_nontemporal_store(pack8(v0, v1), (u32x4*)(C + (size_t)r * DFF + u.pn * 128 + wc * 32 + 8 * fq));
            }
    } break;
    case M_SM: {
        bf16_t* C = (bf16_t*)g.C;
        LAS float* redm = (LAS float*)(lds + 131072 + 16); LAS float* reds = redm + 1024;
#pragma unroll
        for (int ai = 0; ai < 2; ++ai)
#pragma unroll
            for (int m = 0; m < 4; ++m) {
                float v = -3.0e38f;
#pragma unroll
                for (int bj = 0; bj < 2; ++bj)
#pragma unroll
                    for (int n = 0; n < 2; ++n) { const f32x4 x = acc[ai][bj][m][n]; v = fmaxf(v, fmaxf(fmaxf(x[0], x[1]), fmaxf(x[2], x[3]))); }
                v = fmaxf(v, __shfl_xor(v, 16)); v = fmaxf(v, __shfl_xor(v, 32));
                if (fq == 0) redm[(ai * 128 + wr * 64 + m * 16 + fr) * 4 + wc] = v;
            }
        asm volatile("s_waitcnt lgkmcnt(0)" ::: "memory"); __builtin_amdgcn_s_barrier(); asm volatile("" ::: "memory");
#pragma unroll
        for (int ai = 0; ai < 2; ++ai)
#pragma unroll
            for (int m = 0; m < 4; ++m) {
                const int row = ai * 128 + wr * 64 + m * 16 + fr; const f32x4 q = *(const LAS f32x4*)(redm + row * 4);
                const float M = fmaxf(fmaxf(q[0], q[1]), fmaxf(q[2], q[3])); float sum = 0.f;
#pragma unroll
                for (int bj = 0; bj < 2; ++bj)
#pragma unroll
                    for (int n = 0; n < 2; ++n) { f32x4 x = acc[ai][bj][m][n];
#pragma unroll
                        for (int j = 0; j < 4; ++j) { x[j] = __expf(x[j] - M); sum += x[j]; }
                        acc[ai][bj][m][n] = x; }
                sum += __shfl_xor(sum, 16); sum += __shfl_xor(sum, 32);
                if (fq == 0) reds[row * 4 + wc] = sum;
            }
        asm volatile("s_waitcnt lgkmcnt(0)" ::: "memory"); __builtin_amdgcn_s_barrier(); asm volatile("" ::: "memory");
#pragma unroll
        for (int ai = 0; ai < 2; ++ai)
#pragma unroll
            for (int m = 0; m < 4; ++m) {
                const int row = ai * 128 + wr * 64 + m * 16 + fr; const f32x4 q = *(const LAS f32x4*)(reds + row * 4);
                const float inv = 1.0f / ((q[0] + q[1]) + (q[2] + q[3]));
                bf16_t* rowp = C + (size_t)(rbase + ai * 128 + m * 16) * 1024 + u.pn * 256 + wc * 64 + 8 * fq;
#pragma unroll
                for (int bj = 0; bj < 2; ++bj) *(u32x4*)(rowp + bj * 32) = pack8(acc[ai][bj][m][0] * inv, acc[ai][bj][m][1] * inv);
            }
    } break;
    }
}

template <int MODE> __device__ __forceinline__ void gemm_phase(const Params& P, LAS unsigned char* lds, const GemmArgs& g) {
    int tid = threadIdx.x; asm volatile("" : "+v"(tid));
    const int wid = __builtin_amdgcn_readfirstlane(tid >> 6), lane = tid & 63, wr = wid >> 2, wc = wid & 3, fr = lane & 15, fq = lane >> 4;
    const int G = (int)gridDim.x, cidx = (int)(((unsigned)(g.cv >= 0 ? g.cv : (int)blockIdx.x) + gridDim.x - (unsigned)g.shift) % gridDim.x);
    const int K = g.K, nt = K / BK;
    unsigned voffA[2], voffB[2];
#pragma unroll
    for (int i = 0; i < 2; ++i) { int R, C; stage_rc(tid * 16 + i * 8192, R, C); const int Rb = g.perm ? ((R >> 5) * 64 + perm32(R & 31)) : R;
        voffA[i] = (unsigned)(R * g.lda + C) * 2u; voffB[i] = (unsigned)(Rb * g.ldb + C) * 2u; }
    const size_t kstep = (size_t)(BK * 2);
    const size_t hstepA = (size_t)HALF * g.lda * 2, hstepB = (size_t)(g.perm ? 32 : HALF) * g.ldb * 2;
    const unsigned ldsw = (unsigned)wid * 1024u;
    const int aoff = lds_byte(wr * 64 + fr, fq * 8), boff = lds_byte(wc * 32 + fr, fq * 8);
#define PG8_SA(b, h) (((b) * 2 + (h)) * HTB)
#define PG8_SB(b, h) ((4 + (b) * 2 + (h)) * HTB)
#define PG8_STAGE(bufoff, gbase, voff) do { _Pragma("unroll") for (int _i = 0; _i < 2; ++_i) \
        __builtin_amdgcn_global_load_lds((const unsigned*)((const char*)(gbase) + (voff)[_i]), (LAS unsigned*)(lds + (bufoff) + ldsw + _i * 8192), 16, 0, 0); } while (0)
#define PG8_LDA(dst, b, h) do { _Pragma("unroll") for (int m = 0; m < 4; ++m) _Pragma("unroll") for (int k = 0; k < 2; ++k) dst[m][k] = *(const LAS bf16x8*)(lds + PG8_SA(b, h) + aoff + m * 2048 + k * 1024); } while (0)
#define PG8_LDB(dst, b, h) do { _Pragma("unroll") for (int n = 0; n < 2; ++n) _Pragma("unroll") for (int k = 0; k < 2; ++k) dst[n][k] = *(const LAS bf16x8*)(lds + PG8_SB(b, h) + boff + n * 2048 + k * 1024); } while (0)
#define PG8_MMA(ai, bj, At, Bt) do { __builtin_amdgcn_s_setprio(1); _Pragma("unroll") for (int m = 0; m < 4; ++m) _Pragma("unroll") for (int n = 0; n < 2; ++n) _Pragma("unroll") for (int k = 0; k < 2; ++k) \
        acc[ai][bj][m][n] = __builtin_amdgcn_mfma_f32_16x16x32_bf16(Bt[n][k], At[m][k], acc[ai][bj][m][n], 0, 0, 0); __builtin_amdgcn_s_setprio(0); } while (0)
#define PG8_WAIT_V(n) asm volatile("s_waitcnt vmcnt(" #n ")" ::: "memory")
#define PG8_WAIT_L(n) asm volatile("s_waitcnt lgkmcnt(" #n ")" ::: "memory")
#define PG8_BAR __builtin_amdgcn_s_barrier()
#define PG8_SCHED __builtin_amdgcn_sched_barrier(0)
    Unit cur, nxt; int ui = g.i0;
    if (!sched_next(g, G, cidx, ui, cur)) return;
    f32x4 acc[2][2][4][2];
#pragma unroll
    for (int a = 0; a < 2; ++a)
#pragma unroll
        for (int b = 0; b < 2; ++b)
#pragma unroll
            for (int m = 0; m < 4; ++m)
#pragma unroll
                for (int n = 0; n < 2; ++n) acc[a][b][m][n] = (f32x4){0.f, 0.f, 0.f, 0.f};
    bf16x8 At[4][2], B0[2][2], B1[2][2];
    const char* cA = (const char*)g.A + cur.ao; const char* cB = (const char*)g.Bt + cur.bo;
    PG8_STAGE(PG8_SB(0, 0), cB, voffB); PG8_STAGE(PG8_SA(0, 0), cA, voffA); PG8_STAGE(PG8_SB(0, 1), cB + hstepB, voffB); PG8_STAGE(PG8_SA(0, 1), cA + hstepA, voffA);
    if (wr == 1) PG8_BAR;
    PG8_WAIT_V(4); PG8_BAR;
    PG8_STAGE(PG8_SB(1, 0), cB + kstep, voffB); PG8_STAGE(PG8_SA(1, 0), cA + kstep, voffA); PG8_STAGE(PG8_SB(1, 1), cB + hstepB + kstep, voffB);
    PG8_WAIT_V(6); PG8_BAR;
    float ssp[2][4];
#pragma unroll
    for (int a = 0; a < 2; ++a)
#pragma unroll
        for (int m = 0; m < 4; ++m) ssp[a][m] = 0.f;
    for (;;) {
        if (MODE == M_GU || MODE == M_ROWSCALE) {
            const float* ssg = g.F1 + cur.pm * 256 + wr * 64 + fr;
#pragma unroll
            for (int a = 0; a < 2; ++a)
#pragma unroll
                for (int m = 0; m < 4; ++m) ssp[a][m] = ssg[a * 128 + m * 16];
        }
        const bool has_next = sched_next(g, G, cidx, ui + 1, nxt);
        const char* nA = has_next ? (const char*)g.A + nxt.ao : cA; const char* nB = has_next ? (const char*)g.Bt + nxt.bo : cB;
        for (int t = 0; t < nt; t += 2) {
            const bool last = (t == nt - 2);
            const char* a1 = cA + (size_t)(t + 1) * kstep;
            const char* a2 = last ? nA : cA + (size_t)(t + 2) * kstep; const char* b2 = last ? nB : cB + (size_t)(t + 2) * kstep;
            const char* a3 = a2 + kstep; const char* b3 = b2 + kstep;
            PG8_LDB(B0, 0, 0); PG8_SCHED; PG8_LDA(At, 0, 0); PG8_STAGE(PG8_SA(1, 1), a1 + hstepA, voffA);
            PG8_WAIT_L(8); PG8_BAR; PG8_WAIT_L(0); PG8_MMA(0, 0, At, B0); PG8_BAR; PG8_SCHED;
            PG8_LDB(B1, 0, 1); PG8_STAGE(PG8_SB(0, 0), b2, voffB);
            PG8_BAR; PG8_WAIT_L(0); PG8_MMA(0, 1, At, B1); PG8_BAR;
            PG8_LDA(At, 0, 1); PG8_STAGE(PG8_SA(0, 0), a2, voffA);
            PG8_BAR; PG8_WAIT_L(0); PG8_MMA(1, 0, At, B0); PG8_BAR; PG8_SCHED;
            PG8_STAGE(PG8_SB(0, 1), b2 + hstepB, voffB);
            PG8_WAIT_V(6); PG8_BAR; PG8_MMA(1, 1, At, B1); PG8_BAR;
            PG8_LDB(B0, 1, 0); PG8_SCHED; PG8_LDA(At, 1, 0); PG8_STAGE(PG8_SA(0, 1), a2 + hstepA, voffA);
            PG8_WAIT_L(8); PG8_BAR; PG8_WAIT_L(0); PG8_MMA(0, 0, At, B0); PG8_BAR; PG8_SCHED;
            PG8_LDB(B1, 1, 1); PG8_STAGE(PG8_SB(1, 0), b3, voffB);
            PG8_BAR; PG8_WAIT_L(0); PG8_MMA(0, 1, At, B1); PG8_BAR;
            PG8_LDA(At, 1, 1); PG8_STAGE(PG8_SA(1, 0), a3, voffA);
            PG8_BAR; PG8_WAIT_L(0); PG8_MMA(1, 0, At, B0); PG8_BAR; PG8_SCHED;
            PG8_STAGE(PG8_SB(1, 1), b3 + hstepB, voffB);
            PG8_WAIT_V(6); PG8_BAR; PG8_MMA(1, 1, At, B1); PG8_BAR;
        }
        epilogue<MODE>(P, g, acc, cur, wr, wc, fr, fq, lds, ssp);
        if (!has_next) break;
#pragma unroll
        for (int a = 0; a < 2; ++a)
#pragma unroll
            for (int b = 0; b < 2; ++b)
#pragma unroll
                for (int m = 0; m < 4; ++m)
#pragma unroll
                    for (int n = 0; n < 2; ++n) acc[a][b][m][n] = (f32x4){0.f, 0.f, 0.f, 0.f};
        cur = nxt; cA = nA; cB = nB; ++ui;
    }
    PG8_WAIT_V(0);
    if (wr == 0) PG8_BAR;
    PG8_BAR;
#undef PG8_SA
#undef PG8_SB
#undef PG8_STAGE
#undef PG8_LDA
#undef PG8_LDB
#undef PG8_MMA
#undef PG8_WAIT_V
#undef PG8_WAIT_L
#undef PG8_BAR
#undef PG8_SCHED
}

__device__ __forceinline__ void make_gemm(const Params& P, int id, GemmArgs& g) {
    unsigned char* ws = P.ws;
    g.shift = 0; g.i0 = 0; g.i1 = 1 << 20; g.rev = 0; g.cv = -1; g.wgm = WGM; g.X1 = nullptr; g.X2 = nullptr; g.F1 = nullptr; g.H = nullptr; g.C = nullptr; g.ldc = 1024; g.nM = 128; g.nN = 4;
    g.lda = 1024; g.ldb = 1024; g.K = 1024; g.perm = 1; g.sched = SCH_STD;
    switch (id) {
    case G_P1: g.A = (const bf16_t*)(ws + WS_R0); g.Bt = (const bf16_t*)(ws + WS_WIN); g.mode = M_P1; g.nN = 18; break;
    case G_S5E: g.A = (const bf16_t*)(ws + WS_A5); g.Bt = (const bf16_t*)(ws + WS_B5); g.lda = 768; g.ldb = 768; g.K = 512; g.mode = M_F32; g.sched = SCH_S5E;
        g.C = ws + WS_SEND; g.ldc = 256; g.nunits = 128; return;
    case G_K: g.A = (const bf16_t*)(ws + WS_MEMN); g.Bt = (const bf16_t*)(ws + WS_WK); g.mode = M_BF16; g.C = ws + WS_KB; g.nM = 4; g.nN = 4; g.shift = 128; break;
    case G_VT: g.A = (const bf16_t*)(ws + WS_WV); g.Bt = (const bf16_t*)(ws + WS_MEMN); g.mode = M_BF16; g.C = ws + WS_VT; g.nM = 4; g.nN = 4; g.shift = 144; break;
    case G_PB: g.rev = 1; g.A = (const bf16_t*)(ws + WS_R0); g.Bt = (const bf16_t*)(ws + WS_WPB); g.mode = M_MUL; g.C = ws + WS_R1; g.X1 = ws + WS_R4; break;
    case G_S5Y: g.A = (const bf16_t*)(ws + WS_A5); g.Bt = (const bf16_t*)(ws + WS_B5); g.lda = 768; g.ldb = 768; g.K = 768; g.mode = M_S5Y; g.sched = SCH_S5Y;
        g.C = ws + WS_R2; g.nunits = 256; return;
    case G_GLU: g.A = (const bf16_t*)(ws + WS_R2); g.Bt = (const bf16_t*)(ws + WS_WGLU); g.lda = 512; g.ldb = 512; g.K = 512; g.mode = M_GLU; g.C = ws + WS_R2 + 32 * MiB; g.X1 = ws + WS_R2; g.nN = 2; break;
    case G_PA: g.A = (const bf16_t*)(ws + WS_R2 + 32 * MiB); g.Bt = (const bf16_t*)(ws + WS_WPA); g.lda = 512; g.ldb = 512; g.K = 512; g.mode = M_MULADD; g.C = ws + WS_R0; g.X1 = ws + WS_R3; g.X2 = ws + WS_R1; break;
    case G_OUT: g.rev = 1; g.A = (const bf16_t*)(ws + WS_R0); g.Bt = (const bf16_t*)(ws + WS_WOUT); g.mode = M_RESX; g.X1 = P.in[0]; g.H = (bf16_t*)(ws + WS_R1); g.F1 = (float*)(ws + WS_STAT) + 2 * T_TOK; break;
    case G_Q: g.A = (const bf16_t*)(ws + WS_R1); g.Bt = (const bf16_t*)(ws + WS_WQ); g.mode = M_ROWSCALE; g.C = ws + WS_R0; g.F1 = (float*)(ws + WS_STAT) + 2 * T_TOK; break;
    case G_SC: g.A = (const bf16_t*)(ws + WS_R0); g.Bt = (const bf16_t*)(ws + WS_KB); g.K = 256; g.mode = M_SM; g.sched = SCH_ATT_S; g.C = ws + WS_R3; g.nunits = 512; return;
    case G_PV: g.A = (const bf16_t*)(ws + WS_R3); g.Bt = (const bf16_t*)(ws + WS_VT); g.K = 256; g.mode = M_BF16; g.sched = SCH_ATT_PV; g.C = ws + WS_R0; g.nunits = 512; return;
    case G_XO: g.rev = 1; g.A = (const bf16_t*)(ws + WS_R0); g.Bt = (const bf16_t*)(ws + WS_WXO); g.mode = M_RES; g.H = (bf16_t*)(ws + WS_R1); g.F1 = (float*)(ws + WS_STAT) + 3 * T_TOK; break;
    case G_GU: g.A = (const bf16_t*)(ws + WS_R1); g.Bt = (const bf16_t*)(ws + WS_WGU); g.mode = M_GU; g.C = ws + WS_R2; g.F1 = (float*)(ws + WS_STAT) + 3 * T_TOK; g.nN = 22; break;
    default:   g.rev = 1; g.wgm = 16; g.A = (const bf16_t*)(ws + WS_R2); g.Bt = (const bf16_t*)(ws + WS_WD); g.lda = DFF; g.ldb = DFF; g.K = DFF; g.mode = M_RES; g.H = (bf16_t*)(ws + WS_R1); g.F1 = (float*)(ws + WS_STAT) + 4 * T_TOK; break;
    }
    g.nunits = g.nM * g.nN;
}

__device__ __forceinline__ void prep_rows(const float* x, const float* gn, bf16_t* out, int nrows) {
    int tidl = threadIdx.x; asm volatile("" : "+v"(tidl)); const int wid = tidl >> 6, lane = tidl & 63;
    f32x4 g4[4];
#pragma unroll
    for (int i = 0; i < 4; ++i) g4[i] = ((const f32x4*)gn)[lane + 64 * i];
    for (int row0 = (blockIdx.x * 8 + wid) * 4; row0 < nrows; row0 += gridDim.x * 32) {
        f32x4 v[4][4];
#pragma unroll
        for (int rr = 0; rr < 4; ++rr) { const f32x4* p = (const f32x4*)(x + (size_t)(row0 + rr) * 1024);
#pragma unroll
            for (int i = 0; i < 4; ++i) v[rr][i] = __builtin_nontemporal_load(p + lane + 64 * i); }
#pragma unroll
        for (int rr = 0; rr < 4; ++rr) {
            float ss = 0.f;
#pragma unroll
            for (int i = 0; i < 4; ++i) ss += v[rr][i][0] * v[rr][i][0] + v[rr][i][1] * v[rr][i][1] + v[rr][i][2] * v[rr][i][2] + v[rr][i][3] * v[rr][i][3];
            ss = wave_sum(ss); const float rs = rsqrtf(ss * (1.0f / 1024.0f) + EPSV);
#pragma unroll
            for (int i = 0; i < 4; ++i) { const f32x4 o = v[rr][i] * rs * g4[i]; u32x2 w; w.x = cvt_pk_bf16(o[0], o[1]); w.y = cvt_pk_bf16(o[2], o[3]);
                *(u32x2*)(out + (size_t)(row0 + rr) * 1024 + (lane + 64 * i) * 4) = w; }
        }
    }
}

__device__ __forceinline__ void transpose_strip(LAS float* tile, const float* src, int N, bf16_t* dst, int ldd, int mapmode, const float* kscale, float cscale, int tk, int tn) {
    int tid = threadIdx.x; asm volatile("" : "+v"(tid)); const int k0 = tk * 64, n0 = tn * 256;
    f32x4 v[8];
#pragma unroll
    for (int rr = 0; rr < 8; ++rr) { const int i = (tid >> 6) + 8 * rr, j = (tid & 63) * 4; v[rr] = __builtin_nontemporal_load((const f32x4*)(src + (size_t)(k0 + i) * N + n0 + j)); }
#pragma unroll
    for (int rr = 0; rr < 8; ++rr) { const int i = (tid >> 6) + 8 * rr, j = (tid & 63) * 4; const float sc = (kscale ? kscale[k0 + i] : 1.0f) * cscale;
        tile[i * 257 + j] = v[rr][0] * sc; tile[i * 257 + j + 1] = v[rr][1] * sc; tile[i * 257 + j + 2] = v[rr][2] * sc; tile[i * 257 + j + 3] = v[rr][3] * sc; }
    __syncthreads();
#pragma unroll
    for (int q = 0; q < 4; ++q) { const int n = (tid >> 3) + 64 * q, kk = (tid & 7) * 8; f32x4 a, b;
#pragma unroll
        for (int j = 0; j < 4; ++j) { a[j] = tile[(kk + j) * 257 + n]; b[j] = tile[(kk + 4 + j) * 257 + n]; }
        int c = n0 + n; if (mapmode) c = (c >> 7) * 256 + ((c & 127) >> 5) * 64 + (mapmode == 2 ? 32 : 0) + (c & 31);
        *(u32x4*)(dst + (size_t)c * ldd + k0 + kk) = pack8(a, b); }
    __syncthreads();
}

__device__ __forceinline__ void s5_prep_item(const Params& P, LAS unsigned char* lds, int item) {
    const int gg = item >> 3, part = item & 7, tid = threadIdx.x;
    LAS float* LPr = (LAS float*)lds; LAS float* LPi = LPr + 4224; LAS float* BBr = LPi + 4224; LAS float* BBi = BBr + 2048;
    LAS float* CCr = BBi + 2048; LAS float* CCi = CCr + 2048; LAS float* KK = CCi + 2048;
    const float* lam_re = P.in[4]; const float* lam_im = P.in[5]; const float* lstep = P.in[6];
    const float* b_re = P.in[7]; const float* b_im = P.in[8]; const float* c_re = P.in[9]; const float* c_im = P.in[10]; const float* dsk = P.in[11];
    const double INV2PI = 0.15915494309189533577;
    for (int idx = tid; idx < 4224; idx += 512) {
        const int dir = idx / 2112, rem = idx % 2112, tau = rem >> 6, p = rem & 63, q = (dir * 32 + gg) * 64 + p;
        const float step = expf(lstep[dir * 32 + gg]); const float zr = lam_re[q] * step; const double zi = (double)lam_im[q] * (double)step;
        const float mag = expf((float)tau * zr); float c, s; cis_rev(zi * (double)tau * INV2PI, c, s);
        LPr[idx] = mag * c; LPi[idx] = mag * s;
    }
    for (int idx = tid; idx < 2048; idx += 512) {
        const int dir = idx >> 10, p = (idx >> 4) & 63, ci = idx & 15, q = (dir * 32 + gg) * 64 + p;
        const float lr = lam_re[q], li = lam_im[q]; const float step = expf(lstep[dir * 32 + gg]); const float zr = lr * step; const double zi = (double)li * (double)step;
        float c, s, ch, sh; cis_rev(zi * INV2PI, c, s); cis_rev(zi * INV2PI * 0.5, ch, sh);
        const float em1 = expm1f(zr); const float nr = em1 * c - 2.0f * sh * sh, ni = (1.0f + em1) * s;
        const float den = 1.0f / (lr * lr + li * li); const float qr = (nr * lr + ni * li) * den, qi = (ni * lr - nr * li) * den;
        const float br = b_re[q * 16 + ci], bi = b_im[q * 16 + ci];
        BBr[idx] = qr * br - qi * bi; BBi[idx] = qr * bi + qi * br;
    }
    for (int idx = tid; idx < 2048; idx += 512) {
        const int dir = idx >> 10, co = (idx >> 6) & 15, p = idx & 63; const int q = ((dir * 32 + gg) * 16 + co) * 64 + p;
        CCr[idx] = c_re[q]; CCi[idx] = c_im[q];
    }
    __syncthreads();
    bf16_t* B5g = (bf16_t*)(P.ws + WS_B5) + (size_t)gg * 768 * 768;
    if (part < 4) {
        for (int task = tid; task < 1024; task += 512) {
            const int ci4 = task & 3, co = (task >> 2) & 15, tl = (task >> 6) & 7, dir = task >> 9, tau = part * 8 + tl; f32x4 sum = (f32x4){0.f, 0.f, 0.f, 0.f};
            for (int p = 0; p < 64; ++p) {
                const float cr = CCr[dir * 1024 + co * 64 + p], cim = CCi[dir * 1024 + co * 64 + p], lr = LPr[dir * 2112 + tau * 64 + p], li = LPi[dir * 2112 + tau * 64 + p];
                const float xr = cr * lr - cim * li, xi = cr * li + cim * lr;
                const f32x4 br = *(const LAS f32x4*)(BBr + dir * 1024 + p * 16 + ci4 * 4), bi = *(const LAS f32x4*)(BBi + dir * 1024 + p * 16 + ci4 * 4);
                sum += br * xr - bi * xi;
            }
            *(LAS f32x4*)(KK + dir * 2048 + tl * 256 + co * 16 + ci4 * 4) = sum;
        }
        __syncthreads();
        for (int q = tid; q < 16384; q += 512) {
            const int half = q & 1, tl = (q >> 1) & 7, co = (q >> 4) & 15, tt = (q >> 8) & 31, dir = q >> 13, tau = part * 8 + tl;
            int sidx;
            if (dir == 0) { sidx = tt - tau; if (sidx < 0) continue; } else { if (tau == 0) continue; sidx = tt + tau; if (sidx > 31) continue; }
            const LAS float* kp = KK + dir * 2048 + tl * 256 + co * 16 + half * 8;
            f32x4 v0 = *(const LAS f32x4*)kp, v1 = *(const LAS f32x4*)(kp + 4);
            if (tau == 0) {
                const LAS float* kb = KK + 2048 + tl * 256 + co * 16 + half * 8; v0 += *(const LAS f32x4*)kb; v1 += *(const LAS f32x4*)(kb + 4);
                const float dval = dsk[gg * 16 + co]; const int cd = co - half * 8;
                if (cd >= 0 && cd < 8) { if (cd < 4) v0[cd & 3] += dval; else v1[cd & 3] += dval; }
            }
            *(u32x4*)(B5g + (size_t)(tt * 16 + co) * 768 + sidx * 16 + half * 8) = pack8(v0, v1);
        }
    } else if (part < 6) {
        const int dir = part - 4;
        for (int q = tid; q < 8192; q += 512) {
            const int half = q & 1, sx = (q >> 1) & 31, rr = q >> 6, p = rr & 63, isim = rr >> 6; const int e = dir == 0 ? 31 - sx : sx;
            const float lr = LPr[dir * 2112 + e * 64 + p], li = LPi[dir * 2112 + e * 64 + p];
            f32x4 v[2];
#pragma unroll
            for (int k = 0; k < 8; ++k) { const float br = BBr[dir * 1024 + p * 16 + half * 8 + k], bi = BBi[dir * 1024 + p * 16 + half * 8 + k]; v[k >> 2][k & 3] = isim ? (lr * bi + li * br) : (lr * br - li * bi); }
            *(u32x4*)(B5g + (size_t)(512 + dir * 128 + rr) * 768 + sx * 16 + half * 8) = pack8(v[0], v[1]);
        }
    } else {
        const int dir = part - 6;
        for (int task = tid; task < 4096; task += 512) {
            const int p8 = task & 7, n = task >> 3, t = n >> 4, co = n & 15; const int e = dir == 0 ? t + 1 : 32 - t;
            f32x4 vr[2], vi[2];
#pragma unroll
            for (int j = 0; j < 8; ++j) { const int p = p8 * 8 + j; const float cr = CCr[dir * 1024 + co * 64 + p], cim = CCi[dir * 1024 + co * 64 + p], lr = LPr[dir * 2112 + e * 64 + p], li = LPi[dir * 2112 + e * 64 + p];
                vr[j >> 2][j & 3] = cr * lr - cim * li; vi[j >> 2][j & 3] = -(cr * li + cim * lr); }
            bf16_t* dst = B5g + (size_t)n * 768 + 512 + dir * 128 + p8 * 8;
            *(u32x4*)dst = pack8(vr[0], vr[1]); *(u32x4*)(dst + 64) = pack8(vi[0], vi[1]);
        }
    }
    __syncthreads();
}

__device__ __forceinline__ void phase_prep(const Params& P, LAS unsigned char* lds) {
    unsigned char* ws = P.ws; const int tid = threadIdx.x;
    { float* st = (float*)(ws + WS_STAT); for (int i = blockIdx.x * 512 + tid; i < 5 * T_TOK; i += gridDim.x * 512) st[i] = 0.f; }
#pragma unroll 1
    for (int step = 0; step < 2; ++step) {
    if (((step ^ (int)(blockIdx.x & 1u)) & 1) == 0) {
    for (int item = blockIdx.x; item < 256; item += gridDim.x) s5_prep_item(P, lds, item);
    { const float* sw = P.in[15]; bf16_t* o = (bf16_t*)(ws + WS_SW); for (int i = (blockIdx.x * 512 + tid) * 4; i < 8 * 128 * 128; i += gridDim.x * 512 * 4) { const f32x4 v = *(const f32x4*)(sw + i); u32x2 w; w.x = cvt_pk_bf16(v[0], v[1]); w.y = cvt_pk_bf16(v[2], v[3]); *(u32x2*)(o + i) = w; } }
    LAS float* tile = (LAS float*)lds;
    for (int j = blockIdx.x; j < 1248; j += gridDim.x) {
        int t = j; const float* src; int N, ldd, mapmode = 0; bf16_t* dst; const float* ks = nullptr; float cs = 1.0f; int nTn;
        if (t < 288) { src = P.in[3]; N = 4608; dst = (bf16_t*)(ws + WS_WIN); ldd = 1024; nTn = 18; }
        else if ((t -= 288) < 16) { src = P.in[12]; N = 512; dst = (bf16_t*)(ws + WS_WGLU); ldd = 512; nTn = 2; }
        else if ((t -= 16) < 32) { src = P.in[17]; N = 1024; dst = (bf16_t*)(ws + WS_WPA); ldd = 512; nTn = 4; }
        else if ((t -= 32) < 64) { src = P.in[18]; N = 1024; dst = (bf16_t*)(ws + WS_WPB); ldd = 1024; nTn = 4; }
        else if ((t -= 64) < 64) { src = P.in[19]; N = 1024; dst = (bf16_t*)(ws + WS_WOUT); ldd = 1024; nTn = 4; }
        else if ((t -= 64) < 64) { src = P.in[22]; N = 1024; dst = (bf16_t*)(ws + WS_WQ); ldd = 1024; nTn = 4; ks = P.in[20]; cs = 0.0625f; }
        else if ((t -= 64) < 64) { src = P.in[23]; N = 1024; dst = (bf16_t*)(ws + WS_WK); ldd = 1024; nTn = 4; }
        else if ((t -= 64) < 64) { src = P.in[24]; N = 1024; dst = (bf16_t*)(ws + WS_WV); ldd = 1024; nTn = 4; }
        else if ((t -= 64) < 64) { src = P.in[25]; N = 1024; dst = (bf16_t*)(ws + WS_WXO); ldd = 1024; nTn = 4; }
        else if ((t -= 64) < 176) { src = P.in[27]; N = 2816; dst = (bf16_t*)(ws + WS_WGU); ldd = 1024; nTn = 11; ks = P.in[26]; mapmode = 1; }
        else if ((t -= 176) < 176) { src = P.in[28]; N = 2816; dst = (bf16_t*)(ws + WS_WGU); ldd = 1024; nTn = 11; ks = P.in[26]; mapmode = 2; }
        else { t -= 176; src = P.in[29]; N = 1024; dst = (bf16_t*)(ws + WS_WD); ldd = 2816; nTn = 4; }
        transpose_strip(tile, src, N, dst, ldd, mapmode, ks, cs, t / nTn, t % nTn);
    }
    } else {
    prep_rows(P.in[1], P.in[21], (bf16_t*)(ws + WS_MEMN), 1024);
    prep_rows(P.in[0], P.in[2], (bf16_t*)(ws + WS_R0), T_TOK);
    }
    }
}

__device__ __forceinline__ int zt_off(int d, int s) { return d * 256 + ((((s >> 3) ^ ((d & 15) ^ (d >> 4))) & 15) << 4) + (s & 7) * 2; }
__device__ __forceinline__ void phase_sgu(const Params& P, LAS unsigned char* lds) {
    unsigned char* ws = P.ws; int tid = threadIdx.x; asm volatile("" : "+v"(tid)); const int wid = tid >> 6, lane = tid & 63, fr = lane & 15, fq = lane >> 4;
    const bf16_t* ZU = (const bf16_t*)(ws + WS_R1); const bf16_t* ZV = (const bf16_t*)(ws + WS_R2); bf16_t* YB = (bf16_t*)(ws + WS_R0);
    const bf16_t* SW = (const bf16_t*)(ws + WS_SW); const float* zst = (const float*)(ws + WS_STAT);
    const float* lng = P.in[13]; const float* lnb = P.in[14]; const float* bias = P.in[16];
    LAS float* st = (LAS float*)(lds + 65536);
    for (int chunk = blockIdx.x; chunk < 256; chunk += gridDim.x) {
        const int r0 = chunk * 128;
        __syncthreads();
        if (tid < 128) { const float s1 = zst[2 * (r0 + tid)], s2 = zst[2 * (r0 + tid) + 1]; const float mu = s1 * (1.0f / 1024.0f); const float var = fmaxf(s2 * (1.0f / 1024.0f) - mu * mu, 0.f);
            st[2 * tid] = mu; st[2 * tid + 1] = rsqrtf(var + EPSV); }
        __syncthreads();
        const int d8 = tid & 15, sp0 = tid >> 4, t = wid * 16 + fr;
        u32x4 zv[2][2], zu[4]; bf16x8 wf[4]; f32x4 lg0, lg1, lb0, lb1; float bt;
#define SGU_LOAD(hh) do { \
            _Pragma("unroll") for (int it = 0; it < 2; ++it) { const int s0 = (sp0 + 32 * it) * 2; \
                zv[it][0] = *(const u32x4*)(ZV + (size_t)(r0 + s0) * 1024 + (hh) * 128 + d8 * 8); zv[it][1] = *(const u32x4*)(ZV + (size_t)(r0 + s0 + 1) * 1024 + (hh) * 128 + d8 * 8); } \
            _Pragma("unroll") for (int kk = 0; kk < 4; ++kk) wf[kk] = *(const bf16x8*)(SW + (size_t)((hh) * 128 + t) * 128 + kk * 32 + fq * 8); \
            _Pragma("unroll") for (int q = 0; q < 4; ++q) zu[q] = *(const u32x4*)(ZU + (size_t)(r0 + t) * 1024 + (hh) * 128 + q * 32 + fq * 8); \
            lg0 = *(const f32x4*)(lng + (hh) * 128 + d8 * 8); lg1 = *(const f32x4*)(lng + (hh) * 128 + d8 * 8 + 4); lb0 = *(const f32x4*)(lnb + (hh) * 128 + d8 * 8); lb1 = *(const f32x4*)(lnb + (hh) * 128 + d8 * 8 + 4); \
            bt = bias[(hh) * 128 + t]; } while (0)
        SGU_LOAD(0);
#pragma unroll 1
        for (int h = 0; h < 8; ++h) {
            LAS unsigned char* zt = lds + (h & 1) * 32768;
#pragma unroll
            for (int it = 0; it < 2; ++it) {
                const int s0 = (sp0 + 32 * it) * 2;
                f32x4 a0, b0, a1, b1; unpack8(zv[it][0], a0, b0); unpack8(zv[it][1], a1, b1);
                const float mu0 = st[2 * s0], rs0 = st[2 * s0 + 1], mu1 = st[2 * s0 + 2], rs1 = st[2 * s0 + 3];
                a0 = (a0 - mu0) * rs0 * lg0 + lb0; b0 = (b0 - mu0) * rs0 * lg1 + lb1; a1 = (a1 - mu1) * rs1 * lg0 + lb0; b1 = (b1 - mu1) * rs1 * lg1 + lb1;
#pragma unroll
                for (int j = 0; j < 4; ++j) {
                    *(LAS unsigned*)(zt + zt_off(d8 * 8 + j, s0)) = cvt_pk_bf16(a0[j], a1[j]);
                    *(LAS unsigned*)(zt + zt_off(d8 * 8 + 4 + j, s0)) = cvt_pk_bf16(b0[j], b1[j]);
                }
            }
            bf16x8 wfc[4]; u32x4 zuc[4]; const float btc = bt;
#pragma unroll
            for (int kk = 0; kk < 4; ++kk) { wfc[kk] = wf[kk]; zuc[kk] = zu[kk]; }
            if (h < 7) SGU_LOAD(h + 1);
            __syncthreads();
#pragma unroll
            for (int q = 0; q < 4; ++q) {
                f32x4 acc0 = (f32x4){0.f, 0.f, 0.f, 0.f}, acc1 = (f32x4){0.f, 0.f, 0.f, 0.f};
                const int drow = 32 * q + 8 * (fr >> 2) + (fr & 3);
#pragma unroll
                for (int kk = 0; kk < 4; ++kk) {
                    const bf16x8 z0 = *(const LAS bf16x8*)(zt + zt_off(drow, kk * 32 + fq * 8)), z1 = *(const LAS bf16x8*)(zt + zt_off(drow + 4, kk * 32 + fq * 8));
                    acc0 = __builtin_amdgcn_mfma_f32_16x16x32_bf16(z0, wfc[kk], acc0, 0, 0, 0); acc1 = __builtin_amdgcn_mfma_f32_16x16x32_bf16(z1, wfc[kk], acc1, 0, 0, 0); }
                f32x4 za, zb; unpack8(zuc[q], za, zb);
                *(u32x4*)(YB + (size_t)(r0 + t) * 1024 + h * 128 + q * 32 + fq * 8) = pack8(za * (acc0 + btc), zb * (acc1 + btc));
            }
        }
#undef SGU_LOAD
    }
    __syncthreads();
}

__device__ __forceinline__ void scan_item(const Params& P, LAS unsigned char* lds, int gg, int b) {
    unsigned char* ws = P.ws; int tid = threadIdx.x; asm volatile("" : "+v"(tid)); const int wid = tid >> 6, p = tid & 63;
    const float* SEND = (const float*)(ws + WS_SEND); bf16_t* A5 = (bf16_t*)(ws + WS_A5);
    LAS float* le = (LAS float*)lds;
    const double INV2PI = 0.15915494309189533577;
    const size_t rowb = (size_t)gg * 1024 + b * 256;
#pragma unroll 1
    for (int dir = 0; dir < 2; ++dir) {
        const int q = (dir * 32 + gg) * 64 + p;
        const float step = expf(P.in[6][dir * 32 + gg]); const float zr = P.in[4][q] * step; const double zi = (double)P.in[5][q] * (double)step;
        float c, s; cis_rev(zi * 32.0 * INV2PI, c, s); float mag = expf(32.0f * zr); const float l32r = mag * c, l32i = mag * s;
        cis_rev(zi * 1024.0 * INV2PI, c, s); mag = expf(1024.0f * zr); const float lWr = mag * c, lWi = mag * s;
        const int k0 = dir ? 255 - wid * 32 : wid * 32; const long sstride = dir ? -256 : 256, dstride = dir ? -768 : 768;
        const float* srcp = SEND + (rowb + k0) * 256 + dir * 128 + p; bf16_t* dstp = A5 + (rowb + k0) * 768 + 512 + dir * 128 + p;
        float sr[32], si[32];
#pragma unroll
        for (int i = 0; i < 32; ++i) { sr[i] = srcp[0]; si[i] = srcp[64]; srcp += sstride; asm volatile("" : "+v"(srcp)); }
        float cr = 0.f, ci = 0.f;
#pragma unroll
        for (int i = 0; i < 32; ++i) { const float nr = l32r * cr - l32i * ci + sr[i], ni = l32r * ci + l32i * cr + si[i]; cr = nr; ci = ni; }
        __syncthreads();
        le[(wid * 64 + p) * 2] = cr; le[(wid * 64 + p) * 2 + 1] = ci;
        __syncthreads();
        cr = 0.f; ci = 0.f;
        for (int v = 0; v < wid; ++v) { const float er = le[(v * 64 + p) * 2], ei = le[(v * 64 + p) * 2 + 1]; const float nr = lWr * cr - lWi * ci + er, ni = lWr * ci + lWi * cr + ei; cr = nr; ci = ni; }
#pragma unroll
        for (int i = 0; i < 32; ++i) {
            dstp[0] = (bf16_t)(cvt_pk_bf16(cr, 0.f) & 0xffffu); dstp[64] = (bf16_t)(cvt_pk_bf16(ci, 0.f) & 0xffffu); dstp += dstride; asm volatile("" : "+v"(dstp));
            const float nr = l32r * cr - l32i * ci + sr[i], ni = l32r * ci + l32i * cr + si[i]; cr = nr; ci = ni;
        }
    }
    asm volatile("s_waitcnt vmcnt(0)" ::: "memory");
    __syncthreads();
}

__device__ __forceinline__ void phase_softmax(const Params& P) {
    const float* S = P.out; bf16_t* Pm = (bf16_t*)(P.ws + WS_R3);
    int tidl = threadIdx.x; asm volatile("" : "+v"(tidl)); const int wid = tidl >> 6, lane = tidl & 63;
    for (int row0 = (blockIdx.x * 8 + wid) * 8; row0 < T_TOK * 4; row0 += gridDim.x * 64) {
        f32x4 v[8];
#pragma unroll
        for (int rr = 0; rr < 8; ++rr) v[rr] = __builtin_nontemporal_load((const f32x4*)(S + (size_t)(row0 + rr) * 256 + lane * 4));
#pragma unroll
        for (int rr = 0; rr < 8; ++rr) {
            const float mx = wave_max(fmaxf(fmaxf(v[rr][0], v[rr][1]), fmaxf(v[rr][2], v[rr][3])));
            f32x4 e; e[0] = __expf(v[rr][0] - mx); e[1] = __expf(v[rr][1] - mx); e[2] = __expf(v[rr][2] - mx); e[3] = __expf(v[rr][3] - mx);
            const float sum = wave_sum(e[0] + e[1] + e[2] + e[3]); const float inv = 1.0f / sum;
            u32x2 w; w.x = cvt_pk_bf16(e[0] * inv, e[1] * inv); w.y = cvt_pk_bf16(e[2] * inv, e[3] * inv);
            *(u32x2*)(Pm + (size_t)(row0 + rr) * 256 + lane * 4) = w;
        }
    }
}

__device__ __forceinline__ void phase_final(const Params& P) {
    float* out = P.out; const float* ss = (const float*)(P.ws + WS_STAT) + 4 * T_TOK; const float* gn = P.in[30]; const bf16_t* H = (const bf16_t*)(P.ws + WS_R1);
    int tidl = threadIdx.x; asm volatile("" : "+v"(tidl)); const int wid = tidl >> 6, lane = tidl & 63;
    f32x4 g4[4];
#pragma unroll
    for (int j = 0; j < 4; ++j) g4[j] = *(const f32x4*)(gn + j * 256 + lane * 4);
    for (int row0 = (blockIdx.x * 8 + wid) * 8; row0 < T_TOK; row0 += gridDim.x * 64) {
        u32x2 v[8][4]; float rs[8];
#pragma unroll
        for (int rr = 0; rr < 8; ++rr) { rs[rr] = ss[row0 + rr];
#pragma unroll
            for (int j = 0; j < 4; ++j) v[rr][j] = __builtin_nontemporal_load((const u32x2*)(H + (size_t)(row0 + rr) * 1024 + j * 256 + lane * 4)); }
#pragma unroll
        for (int rr = 0; rr < 8; ++rr) { const float r1 = rsqrtf(rs[rr] * (1.0f / 1024.0f) + EPSV);
#pragma unroll
            for (int j = 0; j < 4; ++j) { const f32x4 a = (f32x4){bflo(v[rr][j].x), bfhi(v[rr][j].x), bflo(v[rr][j].y), bfhi(v[rr][j].y)};
                __builtin_nontemporal_store(a * r1 * g4[j], (f32x4*)(out + (size_t)(row0 + rr) * 1024 + j * 256 + lane * 4)); } }
    }
}

#define XB_TMO      128
#define XB_XCNT(j)  (256  + 64 * (j))
#define XB_XSUB(j)  (1280 + 64 * (j))
#define XB_XGEN(j)  (2304 + 64 * (j))
#define XB_TOP      3328
#define XB_TOPGEN   3392
#define XB_LSUB(j)  (3520 + 64 * (j))
#define XB_LGEN(j)  (4544 + 64 * (j))
#define XCD_BAR_WORDS 5568
#define XB_SPIN_CAP (1u << 20)
__device__ __forceinline__ unsigned xb_ld(unsigned* p)              { return __hip_atomic_load(p, __ATOMIC_RELAXED, __HIP_MEMORY_SCOPE_AGENT); }
__device__ __forceinline__ unsigned xb_add(unsigned* p, unsigned v) { return __hip_atomic_fetch_add(p, v, __ATOMIC_RELAXED, __HIP_MEMORY_SCOPE_AGENT); }
__device__ __forceinline__ unsigned xb_xcc_id() { return (unsigned)__builtin_amdgcn_s_getreg((3 << 11) | 20) & 0xFu; }
#define XB_SPIN(cond, bar) do { unsigned _sp = 0; while (cond) { __builtin_amdgcn_s_sleep(1); \
    if ((++_sp & 255u) == 0u) { if (xb_ld(&(bar)[XB_TMO])) break; if (_sp > XB_SPIN_CAP) { atomicAdd(&(bar)[XB_TMO], 1u); break; } } } } while (0)
struct XcdBarrier { unsigned* bar; unsigned x; volatile LAS unsigned* st; };
__device__ __forceinline__ XcdBarrier xcd_barrier_post(unsigned* bar, volatile LAS unsigned* st) {
    XcdBarrier b; b.bar = bar; b.x = xb_xcc_id(); b.st = st;
    if (threadIdx.x == 0) st[2] = xb_add(&bar[XB_XCNT(b.x)], 1u);
    return b;
}
__device__ __forceinline__ void xcd_barrier_complete(unsigned* bar, unsigned x, unsigned& nloc, unsigned& nx, unsigned& info) {
    const unsigned G = gridDim.x * gridDim.y * gridDim.z;
    unsigned sum, cnt, mine, sp = 0u, bad, xd;
    for (;;) {
        sum = 0u; cnt = 0u; mine = 0u; bad = 0u; xd = 0u;
#pragma unroll
        for (unsigned j = 0; j < 16; ++j) { const unsigned c = xb_ld(&bar[XB_XCNT(j)]); sum += c; cnt += (c > 0u) ? 1u : 0u; mine = (j == x) ? c : mine; bad += (c != 0u && c != 32u) ? 1u : 0u; xd += (c > 0u && j < x) ? 1u : 0u; }
        if (sum == G) break;
        __builtin_amdgcn_s_sleep(1);
        if ((++sp & 255u) == 0u) { if (xb_ld(&bar[XB_TMO])) break; if (sp > XB_SPIN_CAP) { atomicAdd(&bar[XB_TMO], 1u); break; } }
    }
    nloc = mine > 0u ? mine : 1u; nx = cnt > 0u ? cnt : 1u;
    info = (sum == G && G == 256u && cnt == 8u && bad == 0u) ? (0x100u | xd) : 0u;
}
__device__ __forceinline__ void xcd_barrier(const XcdBarrier& b) {
    asm volatile("s_waitcnt vmcnt(0)" ::: "memory");
    __syncthreads();
    if (threadIdx.x == 0) {
        unsigned* bar = b.bar;
        __builtin_amdgcn_s_waitcnt(0);
        unsigned nloc = b.st[0], nx = b.st[1];
        if (nloc == 0u) { unsigned info; xcd_barrier_complete(bar, b.x, nloc, nx, info); b.st[0] = nloc; b.st[1] = nx; b.st[3] = info; }
        const unsigned old = xb_add(&bar[XB_XSUB(b.x)], 1u);
        const unsigned gen = old / nloc;
        if (old + 1u == (gen + 1u) * nloc) {
            __builtin_amdgcn_fence(__ATOMIC_RELEASE, "agent");
            asm volatile("s_waitcnt vmcnt(0)" ::: "memory");
            const unsigned og = xb_add(&bar[XB_TOP], 1u);
            const unsigned tg = og / nx;
            if (og + 1u == (tg + 1u) * nx) xb_add(&bar[XB_TOPGEN], 1u);
            else XB_SPIN(xb_ld(&bar[XB_TOPGEN]) == tg, bar);
            __builtin_amdgcn_fence(__ATOMIC_ACQUIRE, "agent");
            xb_add(&bar[XB_XGEN(b.x)], 1u);
            asm volatile("s_waitcnt vmcnt(0)" ::: "memory");
        } else {
            XB_SPIN(xb_ld(&bar[XB_XGEN(b.x)]) == gen, bar);
            __builtin_amdgcn_fence(__ATOMIC_ACQUIRE, "agent");
            asm volatile("s_waitcnt vmcnt(0)" ::: "memory");
        }
    }
    __syncthreads();
}

__device__ __forceinline__ void loc_barrier(const XcdBarrier& b, bool loc) {
    if (!loc) { xcd_barrier(b); return; }
    asm volatile("s_waitcnt vmcnt(0)" ::: "memory");
    __syncthreads();
    if (threadIdx.x == 0) {
        unsigned* bar = b.bar;
        __builtin_amdgcn_s_waitcnt(0);
        const unsigned nloc = b.st[0];
        const unsigned old = xb_add(&bar[XB_LSUB(b.x)], 1u);
        const unsigned gen = old / nloc;
        if (old + 1u == (gen + 1u) * nloc) xb_add(&bar[XB_LGEN(b.x)], 1u);
        else XB_SPIN(xb_ld(&bar[XB_LGEN(b.x)]) == gen, bar);
        __builtin_amdgcn_fence(__ATOMIC_ACQUIRE, "agent");
        asm volatile("s_waitcnt vmcnt(0)" ::: "memory");
    }
    __syncthreads();
}

__global__ void __launch_bounds__(512, 2) mega_fwd(Params P) {
    extern __shared__ __attribute__((aligned(16))) unsigned char shm[];
    LAS unsigned char* lds = (LAS unsigned char*)shm;
    cg::grid_group grid = cg::this_grid();
    volatile LAS unsigned* xst = (volatile LAS unsigned*)(lds + 131072);
    if (threadIdx.x == 0) { xst[0] = 0u; xst[1] = 0u; xst[2] = 0u; xst[3] = 0u; }
    __syncthreads();
    XcdBarrier xb = xcd_barrier_post((unsigned*)(P.ws + WS_BAR), xst);
#define RUNG(MODE, ID) do { GemmArgs ga; make_gemm(P, ID, ga); gemm_phase<MODE>(P, lds, ga); } while (0)
#define RUNL(MODE, ID) do { GemmArgs ga; make_gemm(P, ID, ga); ga.cv = cv; gemm_phase<MODE>(P, lds, ga); } while (0)
    if (P.ws == nullptr) grid.sync();
    phase_prep(P, lds); xcd_barrier(xb);
    const unsigned linfo = (unsigned)__builtin_amdgcn_readfirstlane((int)xst[3]); const bool loc = linfo != 0u;
    const int cv = loc ? (int)((unsigned)__builtin_amdgcn_readfirstlane((int)xst[2]) * 8u + (linfo & 0xffu)) : -1;
    RUNG(M_P1, G_P1); xcd_barrier(xb);
    RUNG(M_F32, G_S5E); RUNG(M_BF16, G_K); RUNG(M_BF16, G_VT); phase_sgu(P, lds); xcd_barrier(xb);
    {
        GemmArgs gy; make_gemm(P, G_S5Y, gy);
        for (int i = 0; i * (int)gridDim.x + (int)blockIdx.x < 256; ++i) {
            const int w = i * (int)gridDim.x + (int)blockIdx.x;
            scan_item(P, lds, w >> 3, w & 3);
            gy.i0 = i; gy.i1 = i + 1; gemm_phase<M_S5Y>(P, lds, gy);
        }
    }
    RUNG(M_MUL, G_PB); xcd_barrier(xb);
    RUNL(M_GLU, G_GLU); loc_barrier(xb, loc);
    RUNL(M_MULADD, G_PA); loc_barrier(xb, loc);
    RUNL(M_RESX, G_OUT); loc_barrier(xb, loc);
    {
        GemmArgs gq, gs, gp; make_gemm(P, G_Q, gq); make_gemm(P, G_SC, gs); make_gemm(P, G_PV, gp);
        gq.sched = SCH_QATT; gq.nunits = 512; gq.cv = cv; gs.cv = cv; gp.cv = cv;
        gemm_phase<M_ROWSCALE>(P, lds, gq);
        gemm_phase<M_SM>(P, lds, gs);
        gemm_phase<M_BF16>(P, lds, gp);
    }
    loc_barrier(xb, loc);
    RUNL(M_RES, G_XO); xcd_barrier(xb);
    RUNL(M_GU, G_GU); loc_barrier(xb, loc);
    RUNL(M_RES, G_DN); xcd_barrier(xb);
    phase_final(P);
#undef RUNG
#undef RUNL
}

extern "C" void kernel_launch(void* const* d_in, const int* in_sizes, int n_in, void* d_out, int out_size, void* d_ws, size_t ws_size, hipStream_t stream) {
    constexpr size_t kDynLds = 131072 + 16 + 8192;
    static int grid_blocks = 0;
    if (!grid_blocks) {
        int dev = 0, cus = 0, per_cu = 0;
        hipGetDevice(&dev);
        hipDeviceGetAttribute(&cus, hipDeviceAttributeMultiprocessorCount, dev);
        hipFuncSetAttribute((const void*)mega_fwd, hipFuncAttributeMaxDynamicSharedMemorySize, (int)kDynLds);
        hipOccupancyMaxActiveBlocksPerMultiprocessor(&per_cu, (const void*)mega_fwd, 512, kDynLds);
        if (per_cu < 1) per_cu = 1;
        grid_blocks = cus * per_cu;
        if (ws_size < WS_END) fprintf(stderr, "workspace too small: %zu < %zu\n", ws_size, (size_t)WS_END);
    }
    Params p{};
    for (int i = 0; i < 31; ++i) p.in[i] = (const float*)d_in[i];
    p.out = (float*)d_out; p.ws = (unsigned char*)d_ws;
    (void)hipMemsetAsync((unsigned char*)d_ws + WS_BAR, 0, XCD_BAR_WORDS * 4, stream);
    void* args[] = {&p};
    hipError_t e = hipLaunchCooperativeKernel((const void*)mega_fwd, dim3(grid_blocks), dim3(512), args, kDynLds, stream);
    if (e != hipSuccess) fprintf(stderr, "cooperative launch failed: %s (grid %d)\n", hipGetErrorString(e), grid_blocks);
}
```
